# Optimizing an MI355X kernel written in HIP

```python
import math
import jax, jax.numpy as jnp
from jax import lax
import numpy as np

D_MODEL = 2048
BATCH = 8
SEQ = 2048
DEPTH = 1

A_HEADS = 8
A_HEAD_DIM = 128
A_WIDTH = A_HEADS * A_HEAD_DIM
MOBA_BLOCK = 256
MOBA_TOPK = 3
MOBA_Q_CHUNK = 16
REL_BUCKETS = 32
REL_MAX_EXACT = 16
REL_MAX_DIST = 128
B_HEADS = 8
B_KEY_DIM = 128
B_VAL_DIM = 128
B_FWIDTH = B_HEADS * B_KEY_DIM
B_IWIDTH = B_HEADS * B_VAL_DIM
HGRN_CHUNK = 64
D_FF = ((8 * D_MODEL // 3 + 255) // 256) * 256
PLE_DIM = 256
NORM_EPS = 1e-6
IN_SIZES = (A_WIDTH, A_WIDTH, A_WIDTH, B_FWIDTH, B_FWIDTH, B_IWIDTH, B_IWIDTH, D_MODEL, D_MODEL)
IN_WIDTH = sum(IN_SIZES)

kernel_name = "hybrid_moba_hgrn2_gated_block"


def rms_norm(x, gain):
    xf = x.astype(jnp.float32)
    y = xf * lax.rsqrt(jnp.mean(xf * xf, axis=-1, keepdims=True) + NORM_EPS)
    return (y * gain.astype(jnp.float32)).astype(x.dtype)


def t5_bucket(rel):
    n = jnp.maximum(rel, 0)
    nf = jnp.maximum(n, REL_MAX_EXACT).astype(jnp.float32)
    large = REL_MAX_EXACT + (jnp.log(nf / REL_MAX_EXACT) / math.log(REL_MAX_DIST / REL_MAX_EXACT)
                             * (REL_BUCKETS - REL_MAX_EXACT)).astype(jnp.int32)
    large = jnp.minimum(large, REL_BUCKETS - 1)
    return jnp.where(n < REL_MAX_EXACT, n, large)


def moba_attention(q, k, v, rel_bias):
    B, S, H, dh = q.shape
    nb = -(-S // MOBA_BLOCK)
    s_pad = nb * MOBA_BLOCK
    pad = ((0, 0), (0, s_pad - S), (0, 0), (0, 0))
    q = q.transpose(0, 2, 1, 3)
    kp = jnp.pad(k, pad).transpose(0, 2, 1, 3).reshape(B, H, nb, MOBA_BLOCK, dh)
    vp = jnp.pad(v, pad).transpose(0, 2, 1, 3).reshape(B, H, nb, MOBA_BLOCK, dh)
    scale = 1.0 / math.sqrt(dh)

    k_mean = jnp.mean(kp.astype(jnp.float32), axis=3)
    scores = jnp.einsum('bhsd,bhnd->bhsn', q.astype(jnp.float32), k_mean)
    q_blk = jnp.arange(S, dtype=jnp.int32) // MOBA_BLOCK
    past = jnp.arange(nb, dtype=jnp.int32)[None, :] < q_blk[:, None]
    scores = jnp.where(past[None, None], scores, -jnp.inf)
    own = jnp.broadcast_to(q_blk[None, None, :, None], (B, H, S, 1))
    n_sel = min(MOBA_TOPK, nb - 1)
    if n_sel > 0:
        _, top_idx = lax.top_k(scores, n_sel)
        top_idx = top_idx.astype(jnp.int32)
        sel = jnp.concatenate([top_idx, own], axis=-1)
        valid = jnp.concatenate([top_idx < own, jnp.ones_like(own, dtype=bool)], axis=-1)
    else:
        sel = own
        valid = jnp.ones_like(own, dtype=bool)
    J = sel.shape[-1]

    nqc = S // MOBA_Q_CHUNK
    def chunks(t):
        return jnp.moveaxis(t.reshape(B, H, nqc, MOBA_Q_CHUNK, *t.shape[3:]), 2, 0)
    xs = (chunks(q), chunks(sel), chunks(valid),
          jnp.arange(S, dtype=jnp.int32).reshape(nqc, MOBA_Q_CHUNK))
    bi = jnp.arange(B)[:, None, None, None]
    hi = jnp.arange(H)[None, :, None, None]
    hi5 = jnp.arange(H)[None, :, None, None, None]
    t_off = jnp.arange(MOBA_BLOCK, dtype=jnp.int32)

    def step(args):
        qc, sel_c, val_c, qpos = args
        kg = kp[bi, hi, sel_c]
        vg = vp[bi, hi, sel_c]
        logits = jnp.einsum('bhqd,bhqjtd->bhqjt', qc, kg).astype(jnp.float32) * scale
        kpos = sel_c[..., None] * MOBA_BLOCK + t_off
        rel = qpos[None, None, :, None, None] - kpos
        bias = rel_bias[t5_bucket(rel), hi5].astype(jnp.float32)
        mask = val_c[..., None] & (rel >= 0)
        logits = jnp.where(mask, logits + bias, -jnp.inf)
        probs = jax.nn.softmax(logits.reshape(B, H, MOBA_Q_CHUNK, J * MOBA_BLOCK), axis=-1)
        probs = probs.reshape(B, H, MOBA_Q_CHUNK, J, MOBA_BLOCK).astype(vg.dtype)
        return jnp.einsum('bhqjt,bhqjtd->bhqd', probs, vg)

    out = lax.map(step, xs)
    return out.transpose(1, 0, 3, 2, 4).reshape(B, S, H * dh)


def hgrn2_mixer(q, f_pre, i_in, g_out, lb, norm_gain):
    B, S, _ = q.shape
    dt = q.dtype
    f = lb.astype(jnp.float32) + (1.0 - lb.astype(jnp.float32)) * jax.nn.sigmoid(f_pre.astype(jnp.float32))
    log_f = jnp.log(f)
    k = 1.0 - f
    nc = S // HGRN_CHUNK
    def chunks(t, d):
        return t.astype(jnp.float32).reshape(B, nc, HGRN_CHUNK, B_HEADS, d).transpose(1, 0, 3, 2, 4)
    qc = chunks(q, B_KEY_DIM)
    kc = chunks(k, B_KEY_DIM)
    gc = chunks(log_f, B_KEY_DIM)
    vc = chunks(i_in, B_VAL_DIM)
    b = jnp.cumsum(gc, axis=3)
    b_last = b[:, :, :, -1:, :]
    q_dec = qc * jnp.exp(b)
    k_dec = kc * jnp.exp(-b)
    k_end = kc * jnp.exp(b_last - b)
    causal = jnp.tril(jnp.ones((HGRN_CHUNK, HGRN_CHUNK), jnp.float32))
    a = jnp.einsum('nbhtd,nbhsd->nbhts', q_dec, k_dec) * causal
    o_intra = jnp.einsum('nbhts,nbhsv->nbhtv', a, vc)

    def scan_fn(state, xs):
        q_d, k_e, v_c, decay = xs
        o_inter = jnp.einsum('bhtd,bhdv->bhtv', q_d, state)
        state = decay[:, :, 0, :, None] * state + jnp.einsum('bhsd,bhsv->bhdv', k_e, v_c)
        return state, o_inter

    s0 = jnp.zeros((B, B_HEADS, B_KEY_DIM, B_VAL_DIM), jnp.float32)
    _, o_inter = lax.scan(scan_fn, s0, (q_dec, k_end, vc, jnp.exp(b_last)))
    o = (o_intra + o_inter).transpose(1, 0, 3, 2, 4).reshape(B, S, B_HEADS, B_VAL_DIM)
    o = rms_norm(o.astype(dt), norm_gain.reshape(B_HEADS, B_VAL_DIM)).reshape(B, S, B_IWIDTH)
    return o * jax.nn.silu(g_out)


def setup_inputs(seed: int = 0) -> dict:
    key = jax.random.key(seed)
    ks = jax.random.split(key, 16)
    def w(k, shape, fan_in):
        return jax.random.normal(k, shape, jnp.float32) * fan_in ** -0.5
    def gain(k, shape):
        return 1.0 + 0.01 * jax.random.normal(k, shape, jnp.float32)
    return {
        "x": jax.random.normal(ks[0], (BATCH, SEQ, D_MODEL), jnp.float32),
        "p": jax.random.normal(ks[1], (DEPTH, BATCH, SEQ, PLE_DIM), jnp.float32),
        "norm_mix": gain(ks[2], (DEPTH, D_MODEL)),
        "w_in": w(ks[3], (DEPTH, D_MODEL, IN_WIDTH), D_MODEL),
        "hgrn_norm": gain(ks[4], (DEPTH, B_IWIDTH)),
        "w_proj_a": w(ks[5], (DEPTH, A_WIDTH, D_MODEL), A_WIDTH),
        "w_proj_b": w(ks[6], (DEPTH, B_IWIDTH, D_MODEL), B_IWIDTH),
        "w_out": w(ks[7], (DEPTH, D_MODEL, D_MODEL), D_MODEL),
        "norm_ffn": gain(ks[8], (DEPTH, D_MODEL)),
        "w_gate_up": w(ks[9], (DEPTH, D_MODEL, 2 * D_FF), D_MODEL),
        "w_down": w(ks[10], (DEPTH, D_FF, D_MODEL), D_FF),
        "w_ple": w(ks[11], (DEPTH, PLE_DIM, D_MODEL), PLE_DIM),
        "w_ple_gate": w(ks[12], (DEPTH, D_MODEL, D_MODEL), D_MODEL),
        "rel_bias": 0.1 * jax.random.normal(ks[13], (REL_BUCKETS, A_HEADS), jnp.float32),
        "hgrn_lb_logits": 0.1 * jax.random.normal(ks[14], (DEPTH + 1, B_FWIDTH), jnp.float32),
        "norm_final": gain(ks[15], (D_MODEL,)),
    }


def reference(x, p, norm_mix, w_in, hgrn_norm, w_proj_a, w_proj_b, w_out, norm_ffn, w_gate_up,
              w_down, w_ple, w_ple_gate, rel_bias, hgrn_lb_logits, norm_final):
    B, S, _ = x.shape
    split_points = list(np.cumsum(IN_SIZES)[:-1])
    lb_all = jnp.cumsum(jax.nn.softmax(hgrn_lb_logits.astype(jnp.float32), axis=0), axis=0)
    for i in range(DEPTH):
        h = rms_norm(x, norm_mix[i])
        proj = h @ w_in[i]
        qa, ka, va, qb, fb, ib, gb, gate_a, gate_b = jnp.split(proj, split_points, axis=-1)
        ya = moba_attention(qa.reshape(B, S, A_HEADS, A_HEAD_DIM),
                            ka.reshape(B, S, A_HEADS, A_HEAD_DIM),
                            va.reshape(B, S, A_HEADS, A_HEAD_DIM), rel_bias)
        yb = hgrn2_mixer(qb, fb, ib, gb, lb_all[i], hgrn_norm[i])
        mixed = jax.nn.sigmoid(gate_a) * (ya @ w_proj_a[i]) + jax.nn.sigmoid(gate_b) * (yb @ w_proj_b[i])
        x = x + mixed @ w_out[i]
        h = rms_norm(x, norm_ffn[i])
        gate, up = jnp.split(h @ w_gate_up[i], 2, axis=-1)
        x = x + (jax.nn.silu(gate) * up) @ w_down[i]
        x = x + jax.nn.sigmoid(x @ w_ple_gate[i]) * (p[i] @ w_ple[i])
    return rms_norm(x, norm_final)
```

```cpp
#define MK_N_LAUNCHES 10
#include <hip/hip_runtime.h>
#include <cstdio>
#include <cstdint>
namespace pg8 {
#define PG8_LAS __attribute__((address_space(3)))
typedef unsigned short bf16_t;
typedef short bf16x8 __attribute__((ext_vector_type(8)));
typedef float f32x4 __attribute__((ext_vector_type(4)));
typedef unsigned u32x4 __attribute__((ext_vector_type(4)));
constexpr int BM = 256, BK = 64, HALF = 128, HTB = HALF * BK * 2  , STAGE_BYTES = 8 * HTB, NXCD = 8, WGM = 8;

__host__ __device__ __forceinline__ int lds_byte(int r, int c) { const int st = (r >> 4) * 2 + (c >> 5), rr = r & 15, cc = c & 31, ob = rr * 64 + cc * 2; return st * 1024 + (ob ^ (((ob >> 9) & 1) << 5)); }
__host__ __device__ __forceinline__ void stage_rc(int b, int& R, int& C) { const int st = b / 1024, sb = b % 1024, swz = sb ^ (((sb >> 9) & 1) << 5); R = (st >> 1) * 16 + swz / 64; C = (st & 1) * 32 + (swz % 64) / 2; }
__host__ __device__ __forceinline__ int perm32(int rho) { const int n = rho >> 4, i = rho & 15; return 8 * (i >> 2) + 4 * n + (i & 3); }

struct Unit { int pm, pn; };
struct Gemm { const bf16_t* A; const bf16_t* Bt; int M, N, K; };

struct StaticOrder {
    int nM, nN, nwg, G, c;
    __host__ __device__ void init(int M, int N, int G_, int c_) { nM = M / BM; nN = N / BM; nwg = nM * nN; G = G_; c = c_; }
    __host__ __device__ bool next(int i, Unit& u) const {
        const long L = (long)i * G + c; if (L >= nwg) return false;
        int wgid = (int)L; { const int q = nwg / NXCD, r = nwg % NXCD, xcd = wgid % NXCD, off = wgid / NXCD; wgid = (xcd < r ? xcd * (q + 1) : r * (q + 1) + (xcd - r) * q) + off; }
        const int nig = WGM * nN, gid = wgid / nig, fm = gid * WGM, gsz = (nM - fm) < WGM ? (nM - fm) : WGM;
        u.pm = fm + ((wgid % nig) % gsz); u.pn = (wgid % nig) / gsz; return true;
    }
    __device__ __forceinline__ void a_ready(const Unit&) const {}
    __device__ __forceinline__ void done(const Unit&) const {}
};
__device__ __forceinline__ unsigned cvt_pk_bf16(float lo, float hi) { unsigned r; asm volatile("v_cvt_pk_bf16_f32 %0, %1, %2" : "=v"(r) : "v"(lo), "v"(hi)); return r; }
typedef float f32x2 __attribute__((ext_vector_type(2)));
__device__ __forceinline__ float sigm(float v) { return __builtin_amdgcn_rcpf(1.0f + __expf(-v)); }
__device__ __forceinline__ float bf_lo(unsigned w) { return __uint_as_float(w << 16); }
__device__ __forceinline__ float bf_hi(unsigned w) { return __uint_as_float(w & 0xffff0000u); }
__device__ __forceinline__ u32x4 pack8(f32x4 v0, f32x4 v1) { u32x4 w; w.x = cvt_pk_bf16(v0[0], v0[1]); w.y = cvt_pk_bf16(v0[2], v0[3]); w.z = cvt_pk_bf16(v1[0], v1[1]); w.w = cvt_pk_bf16(v1[2], v1[3]); return w; }
typedef unsigned u32x2 __attribute__((ext_vector_type(2)));

struct EpiInProj {
    static constexpr bool PERM = true, AFTER_DRAIN = false;
    bf16_t *Q, *K, *V, *QB, *IB, *SG, *GA, *GB; float* F; const PG8_LAS float* tab; const float* lb;
    __device__ __forceinline__ void operator()(const f32x4 (&acc)[2][2][4][2], const Unit& u, int wr, int wc, int fr, int fq) const {
        const int seg = u.pn >> 2; const int rl0 = wr * 64 + fr, row0 = u.pm * BM + rl0;
        int mode = 0, ldc = 1024, colt = (u.pn & 3) * 256; bf16_t* ob = Q;
        if (seg == 1) ob = K; else if (seg == 2) ob = V; else if (seg == 3) ob = QB; else if (seg == 4) mode = 1; else if (seg == 5) ob = IB; else if (seg == 6) { ob = SG; mode = 2; }
        else if (seg == 7 || seg == 8) { ob = GA; mode = 3; ldc = 2048; colt = (u.pn - 28) * 256; } else if (seg >= 9) { ob = GB; mode = 3; ldc = 2048; colt = (u.pn - 36) * 256; }
        const int col0 = colt + wc * 32 + 8 * fq;
        if (mode == 1) {
            f32x4 lbv[2][2];
#pragma unroll
            for (int bj = 0; bj < 2; ++bj)
#pragma unroll
                for (int n = 0; n < 2; ++n) lbv[bj][n] = *(const f32x4*)(lb + col0 + bj * HALF + 4 * n);
#pragma unroll
            for (int ai = 0; ai < 2; ++ai)
#pragma unroll
                for (int m = 0; m < 4; ++m) { const int row = row0 + ai * HALF + m * 16; const float r = tab[rl0 + ai * HALF + m * 16]; float* rowp = F + (size_t)row * 1024 + col0;
#pragma unroll
                    for (int bj = 0; bj < 2; ++bj)
#pragma unroll
                        for (int n = 0; n < 2; ++n) { f32x4 v = acc[ai][bj][m][n] * r, o; const f32x4 l = lbv[bj][n];
#pragma unroll
                            for (int j = 0; j < 4; ++j) o[j] = l[j] + (1.0f - l[j]) * sigm(v[j]);
                            *(f32x4*)(rowp + bj * HALF + 4 * n) = o; } }
        } else {
#pragma unroll
            for (int ai = 0; ai < 2; ++ai)
#pragma unroll
                for (int m = 0; m < 4; ++m) { const int row = row0 + ai * HALF + m * 16; const float r = tab[rl0 + ai * HALF + m * 16]; bf16_t* rowp = ob + (size_t)row * ldc + col0;
#pragma unroll
                    for (int bj = 0; bj < 2; ++bj) { f32x4 v0 = acc[ai][bj][m][0] * r, v1 = acc[ai][bj][m][1] * r;
                        if (mode == 2) {
#pragma unroll
                            for (int j = 0; j < 4; ++j) { v0[j] = v0[j] * sigm(v0[j]); v1[j] = v1[j] * sigm(v1[j]); } }
                        if (mode == 3) {
#pragma unroll
                            for (int j = 0; j < 4; ++j) { v0[j] = sigm(v0[j]); v1[j] = sigm(v1[j]); } }
                        *(u32x4*)(rowp + bj * HALF) = pack8(v0, v1); } }
        }
    }
};
template <bool ADD> struct EpiMix {
    static constexpr bool PERM = true, AFTER_DRAIN = false;
    bf16_t* MIX; const bf16_t* G;
    __device__ __forceinline__ void operator()(const f32x4 (&acc)[2][2][4][2], const Unit& u, int wr, int wc, int fr, int fq) const {
        const int row0 = u.pm * BM + wr * 64 + fr, col0 = u.pn * BM + wc * 32 + 8 * fq;
#pragma unroll
        for (int ai = 0; ai < 2; ++ai)
#pragma unroll
            for (int m = 0; m < 4; ++m) { const size_t off = (size_t)(row0 + ai * HALF + m * 16) * 2048 + col0;
#pragma unroll
                for (int bj = 0; bj < 2; ++bj) { const u32x4 g = *(const u32x4*)(G + off + bj * HALF);
                    f32x4 v0 = acc[ai][bj][m][0], v1 = acc[ai][bj][m][1];
                    v0[0] *= bf_lo(g.x); v0[1] *= bf_hi(g.x); v0[2] *= bf_lo(g.y); v0[3] *= bf_hi(g.y); v1[0] *= bf_lo(g.z); v1[1] *= bf_hi(g.z); v1[2] *= bf_lo(g.w); v1[3] *= bf_hi(g.w);
                    if (ADD) { const u32x4 t = *(const u32x4*)(MIX + off + bj * HALF);
                        v0[0] += bf_lo(t.x); v0[1] += bf_hi(t.x); v0[2] += bf_lo(t.y); v0[3] += bf_hi(t.y); v1[0] += bf_lo(t.z); v1[1] += bf_hi(t.z); v1[2] += bf_lo(t.w); v1[3] += bf_hi(t.w); }
                    *(u32x4*)(MIX + off + bj * HALF) = pack8(v0, v1); } }
    }
};
template <bool SS> struct EpiResid {
    static constexpr bool PERM = false, AFTER_DRAIN = false;
    const float* XI; float* XO; bf16_t* XB; float* SSP;
    __device__ __forceinline__ void operator()(const f32x4 (&acc)[2][2][4][2], const Unit& u, int wr, int wc, int fr, int fq) const {
        const int row0 = u.pm * BM + wr * 64 + fr, col0 = u.pn * BM + wc * 32 + 4 * fq;
#pragma unroll
        for (int ai = 0; ai < 2; ++ai)
#pragma unroll
            for (int m = 0; m < 4; ++m) { const int row = row0 + ai * HALF + m * 16; const size_t off = (size_t)row * 2048 + col0; float s = 0.f;
#pragma unroll
                for (int bj = 0; bj < 2; ++bj)
#pragma unroll
                    for (int n = 0; n < 2; ++n) { const f32x4 o = *(const f32x4*)(XI + off + bj * HALF + n * 16) + acc[ai][bj][m][n];
                        *(f32x4*)(XO + off + bj * HALF + n * 16) = o; s += (o[0] * o[0] + o[1] * o[1]) + (o[2] * o[2] + o[3] * o[3]);
                        u32x2 w; w.x = cvt_pk_bf16(o[0], o[1]); w.y = cvt_pk_bf16(o[2], o[3]); *(u32x2*)(XB + off + bj * HALF + n * 16) = w; }
                if (SS) { s += __shfl_xor(s, 16); s += __shfl_xor(s, 32); if (fq == 0) SSP[(size_t)row * 32 + u.pn * 4 + wc] = s; } }
    }
};
struct EpiGateUp {
    static constexpr bool PERM = true, AFTER_DRAIN = false;
    bf16_t* ACT; const PG8_LAS float* tab; int ldc;
    __device__ __forceinline__ void operator()(const f32x4 (&acc)[2][2][4][2], const Unit& u, int wr, int wc, int fr, int fq) const {
        const int col0 = u.pn * 128 + wc * 32 + 8 * fq;
#pragma unroll
        for (int ai = 0; ai < 2; ++ai)
#pragma unroll
            for (int m = 0; m < 4; ++m) { const int rl = ai * HALF + wr * 64 + m * 16 + fr; const float r = tab[rl];
                f32x4 a0, a1;
#pragma unroll
                for (int j = 0; j < 4; ++j) { const float g0 = acc[ai][0][m][0][j] * r, g1 = acc[ai][0][m][1][j] * r; a0[j] = g0 * sigm(g0) * (acc[ai][1][m][0][j] * r); a1[j] = g1 * sigm(g1) * (acc[ai][1][m][1][j] * r); }
                *(u32x4*)(ACT + (size_t)(u.pm * BM + rl) * ldc + col0) = pack8(a0, a1); }
    }
};
struct EpiPle {
    static constexpr bool PERM = false, AFTER_DRAIN = false;
    bf16_t* O;
    __device__ __forceinline__ void operator()(const f32x4 (&acc)[2][2][4][2], const Unit& u, int wr, int wc, int fr, int fq) const {
        const int row0 = u.pm * BM + wr * 64 + fr, col0 = u.pn * BM + wc * 32 + 4 * fq;
#pragma unroll
        for (int ai = 0; ai < 2; ++ai)
#pragma unroll
            for (int m = 0; m < 4; ++m) { const size_t off = (size_t)(row0 + ai * HALF + m * 16) * 2048 + col0;
#pragma unroll
                for (int bj = 0; bj < 2; ++bj)
#pragma unroll
                    for (int n = 0; n < 2; ++n) { const f32x4 o = acc[ai][bj][m][n]; u32x2 w; w.x = cvt_pk_bf16(o[0], o[1]); w.y = cvt_pk_bf16(o[2], o[3]); *(u32x2*)(O + off + bj * HALF + n * 16) = w; } }
    }
};
struct EpiPleGate {
    static constexpr bool PERM = false, AFTER_DRAIN = false;
    float* X; const bf16_t* PLE; float* SSP;
    __device__ __forceinline__ void operator()(const f32x4 (&acc)[2][2][4][2], const Unit& u, int wr, int wc, int fr, int fq) const {
        const int row0 = u.pm * BM + wr * 64 + fr, col0 = u.pn * BM + wc * 32 + 4 * fq;
#pragma unroll
        for (int ai = 0; ai < 2; ++ai)
#pragma unroll
            for (int m = 0; m < 4; ++m) { const int row = row0 + ai * HALF + m * 16; const size_t off = (size_t)row * 2048 + col0; float s = 0.f;
#pragma unroll
                for (int bj = 0; bj < 2; ++bj)
#pragma unroll
                    for (int n = 0; n < 2; ++n) { const f32x4 a = acc[ai][bj][m][n]; const u32x2 pl = *(const u32x2*)(PLE + off + bj * HALF + n * 16); f32x4 o = *(const f32x4*)(X + off + bj * HALF + n * 16);
                        o[0] += sigm(a[0]) * bf_lo(pl.x); o[1] += sigm(a[1]) * bf_hi(pl.x); o[2] += sigm(a[2]) * bf_lo(pl.y); o[3] += sigm(a[3]) * bf_hi(pl.y);
                        *(f32x4*)(X + off + bj * HALF + n * 16) = o; s += (o[0] * o[0] + o[1] * o[1]) + (o[2] * o[2] + o[3] * o[3]); }
                s += __shfl_xor(s, 16); s += __shfl_xor(s, 32); if (fq == 0) SSP[(size_t)row * 32 + u.pn * 4 + wc] = s;
                asm volatile("" ::: "memory"); }
    }
};

template <class Epi, class Sched, bool ALIGN_EPI = false, bool SP2 = false>
__device__ __forceinline__ void gemm_phase(PG8_LAS unsigned char* lds, const Gemm g, const Sched& S, const Epi& E) {
    int tid_ = threadIdx.x; asm volatile("" : "+v"(tid_));
    const int tid = tid_, wid = __builtin_amdgcn_readfirstlane(tid >> 6), lane = tid & 63, wr = wid >> 2, wc = wid & 3, fr = lane & 15, fq = lane >> 4;
    const int K = g.K, nt = K / BK;
    unsigned voffA[2], voffB[2];
#pragma unroll
    for (int i = 0; i < 2; ++i) { int R, C; stage_rc(tid * 16 + i * 8192, R, C); const int Rb = Epi::PERM ? ((R & ~31) + perm32(R & 31)) : R;
        voffA[i] = (unsigned)(R * K + C) * 2u; voffB[i] = (unsigned)(Rb * K + C) * 2u; }
    const size_t kstep = (size_t)(BK * 2);
    const size_t hstep = (size_t)HALF * K * 2;
    const size_t tstep = 2 * hstep;
    const unsigned ldsw = (unsigned)wid * 1024u;
    const int aoff = lds_byte(wr * 64 + fr, fq * 8), boff = lds_byte(wc * 32 + fr, fq * 8);
#define PG8_SA(b, h) (((b) * 2 + (h)) * HTB)
#define PG8_SB(b, h) ((4 + (b) * 2 + (h)) * HTB)
#define PG8_STAGE(bufoff, gbase, voff) do { _Pragma("unroll") for (int _i = 0; _i < 2; ++_i) \
        __builtin_amdgcn_global_load_lds((const unsigned*)((const char*)(gbase) + (voff)[_i]), (PG8_LAS unsigned*)(lds + (bufoff) + ldsw + _i * 8192), 16, 0, 0); } while (0)
#define PG8_LDA(dst, b, h) do { _Pragma("unroll") for (int m = 0; m < 4; ++m) _Pragma("unroll") for (int k = 0; k < 2; ++k) dst[m][k] = *(const PG8_LAS bf16x8*)(lds + PG8_SA(b, h) + aoff + m * 2048 + k * 1024); } while (0)
#define PG8_LDB(dst, b, h) do { _Pragma("unroll") for (int n = 0; n < 2; ++n) _Pragma("unroll") for (int k = 0; k < 2; ++k) dst[n][k] = *(const PG8_LAS bf16x8*)(lds + PG8_SB(b, h) + boff + n * 2048 + k * 1024); } while (0)
#define PG8_MMA(ai, bj, At, Bt) do { __builtin_amdgcn_s_setprio(1); _Pragma("unroll") for (int m = 0; m < 4; ++m) _Pragma("unroll") for (int n = 0; n < 2; ++n) _Pragma("unroll") for (int k = 0; k < 2; ++k) \
        acc[ai][bj][m][n] = __builtin_amdgcn_mfma_f32_16x16x32_bf16(Bt[n][k], At[m][k], acc[ai][bj][m][n], 0, 0, 0); __builtin_amdgcn_s_setprio(0); } while (0)
#define PG8_WAIT_V(n) asm volatile("s_waitcnt vmcnt(" #n ")" ::: "memory")
#define PG8_WAIT_L(n) asm volatile("s_waitcnt lgkmcnt(" #n ")" ::: "memory")
#define PG8_BAR __builtin_amdgcn_s_barrier()
#define PG8_SCHED __builtin_amdgcn_sched_barrier(0)
    Unit cur, nxt; int ui = 0;
    if (!S.next(0, cur)) return;
    f32x4 acc[2][2][4][2];
#pragma unroll
    for (int a = 0; a < 2; ++a)
#pragma unroll
        for (int b = 0; b < 2; ++b)
#pragma unroll
            for (int m = 0; m < 4; ++m)
#pragma unroll
                for (int n = 0; n < 2; ++n) acc[a][b][m][n] = (f32x4){0.f, 0.f, 0.f, 0.f};
    bf16x8 At[4][2], B0[2][2], B1[2][2];
    const char* cA = (const char*)g.A + (size_t)cur.pm * tstep; const char* cB = (const char*)g.Bt + (size_t)cur.pn * tstep;
    S.a_ready(cur);
    if constexpr (SP2) {
        PG8_STAGE(PG8_SB(0, 0), cB, voffB); PG8_STAGE(PG8_SB(0, 1), cB + hstep, voffB); PG8_STAGE(PG8_SA(0, 0), cA, voffA); PG8_STAGE(PG8_SA(0, 1), cA + hstep, voffA);
        if (wr == 1) PG8_BAR;
        PG8_WAIT_V(2); PG8_BAR;
        PG8_STAGE(PG8_SB(1, 0), cB + kstep, voffB); PG8_STAGE(PG8_SA(1, 0), cA + kstep, voffA); PG8_STAGE(PG8_SB(1, 1), cB + hstep + kstep, voffB);
        PG8_WAIT_V(6); PG8_BAR;
    } else {
        PG8_STAGE(PG8_SB(0, 0), cB, voffB); PG8_STAGE(PG8_SA(0, 0), cA, voffA); PG8_STAGE(PG8_SB(0, 1), cB + hstep, voffB); PG8_STAGE(PG8_SA(0, 1), cA + hstep, voffA);
        if (wr == 1) PG8_BAR;
        PG8_WAIT_V(4); PG8_BAR;
        PG8_STAGE(PG8_SB(1, 0), cB + kstep, voffB); PG8_STAGE(PG8_SA(1, 0), cA + kstep, voffA); PG8_STAGE(PG8_SB(1, 1), cB + hstep + kstep, voffB);
        PG8_WAIT_V(6); PG8_BAR;
    }
    for (;;) {
        const bool has_next = S.next(ui + 1, nxt);
        const char* nA = has_next ? (const char*)g.A + (size_t)nxt.pm * tstep : cA; const char* nB = has_next ? (const char*)g.Bt + (size_t)nxt.pn * tstep : cB;
        for (int t = 0; t < nt; t += 2) {
            const bool last = (t == nt - 2);
            const char* a1 = cA + (size_t)(t + 1) * kstep;
            const char* a2 = last ? nA : cA + (size_t)(t + 2) * kstep; const char* b2 = last ? nB : cB + (size_t)(t + 2) * kstep;
            const char* a3 = a2 + kstep; const char* b3 = b2 + kstep;
            if (last && has_next) S.a_ready(nxt);
            if constexpr (SP2) {
            PG8_LDB(B0, 0, 0); PG8_LDB(B1, 0, 1); PG8_SCHED; PG8_LDA(At, 0, 0); PG8_STAGE(PG8_SA(1, 1), a1 + hstep, voffA);
            PG8_WAIT_V(8); PG8_WAIT_L(0); PG8_BAR; PG8_MMA(0, 0, At, B0); PG8_MMA(0, 1, At, B1); PG8_BAR; PG8_SCHED;
            PG8_LDA(At, 0, 1); PG8_STAGE(PG8_SB(0, 0), b2, voffB); PG8_STAGE(PG8_SB(0, 1), b2 + hstep, voffB); PG8_STAGE(PG8_SA(0, 0), a2, voffA);
            PG8_WAIT_V(8); PG8_WAIT_L(0); PG8_BAR; PG8_MMA(1, 0, At, B0); PG8_MMA(1, 1, At, B1); PG8_BAR; PG8_SCHED;
            PG8_LDB(B0, 1, 0); PG8_LDB(B1, 1, 1); PG8_SCHED; PG8_LDA(At, 1, 0); PG8_STAGE(PG8_SA(0, 1), a2 + hstep, voffA);
            PG8_WAIT_V(8); PG8_WAIT_L(0); PG8_BAR; PG8_MMA(0, 0, At, B0); PG8_MMA(0, 1, At, B1); PG8_BAR; PG8_SCHED;
            PG8_LDA(At, 1, 1); PG8_STAGE(PG8_SB(1, 0), b3, voffB); PG8_STAGE(PG8_SB(1, 1), b3 + hstep, voffB); PG8_STAGE(PG8_SA(1, 0), a3, voffA);
            PG8_WAIT_V(8); PG8_WAIT_L(0); PG8_BAR; PG8_MMA(1, 0, At, B0); PG8_MMA(1, 1, At, B1); PG8_BAR; PG8_SCHED;
            } else {
            PG8_LDB(B0, 0, 0); PG8_SCHED; PG8_LDA(At, 0, 0); PG8_STAGE(PG8_SA(1, 1), a1 + hstep, voffA);
            PG8_WAIT_L(8); PG8_BAR; PG8_WAIT_L(0); PG8_MMA(0, 0, At, B0); PG8_BAR; PG8_SCHED;
            PG8_LDB(B1, 0, 1); PG8_STAGE(PG8_SB(0, 0), b2, voffB);
            PG8_BAR; PG8_WAIT_L(0); PG8_MMA(0, 1, At, B1); PG8_BAR;
            PG8_LDA(At, 0, 1); PG8_STAGE(PG8_SA(0, 0), a2, voffA);
            PG8_BAR; PG8_WAIT_L(0); PG8_MMA(1, 0, At, B0); PG8_BAR; PG8_SCHED;
            PG8_STAGE(PG8_SB(0, 1), b2 + hstep, voffB);
            PG8_WAIT_V(6); PG8_BAR; PG8_MMA(1, 1, At, B1); PG8_BAR;
            PG8_LDB(B0, 1, 0); PG8_SCHED; PG8_LDA(At, 1, 0); PG8_STAGE(PG8_SA(0, 1), a2 + hstep, voffA);
            PG8_WAIT_L(8); PG8_BAR; PG8_WAIT_L(0); PG8_MMA(0, 0, At, B0); PG8_BAR; PG8_SCHED;
            PG8_LDB(B1, 1, 1); PG8_STAGE(PG8_SB(1, 0), b3, voffB);
            PG8_BAR; PG8_WAIT_L(0); PG8_MMA(0, 1, At, B1); PG8_BAR;
            PG8_LDA(At, 1, 1); PG8_STAGE(PG8_SA(1, 0), a3, voffA);
            PG8_BAR; PG8_WAIT_L(0); PG8_MMA(1, 0, At, B0); PG8_BAR; PG8_SCHED;
            PG8_STAGE(PG8_SB(1, 1), b3 + hstep, voffB);
            PG8_WAIT_V(6); PG8_BAR; PG8_MMA(1, 1, At, B1); PG8_BAR;
            }
        }
        if constexpr (ALIGN_EPI) { if (wr == 0) PG8_BAR; }
        if constexpr (!Epi::AFTER_DRAIN) { E(acc, cur, wr, wc, fr, fq); S.done(cur); }
        if (!has_next) break;
#pragma unroll
        for (int a = 0; a < 2; ++a)
#pragma unroll
            for (int b = 0; b < 2; ++b)
#pragma unroll
                for (int m = 0; m < 4; ++m)
#pragma unroll
                    for (int n = 0; n < 2; ++n) acc[a][b][m][n] = (f32x4){0.f, 0.f, 0.f, 0.f};
        cur = nxt; cA = nA; cB = nB; ++ui;
        if constexpr (ALIGN_EPI) { if (wr == 1) PG8_BAR; }
    }
    PG8_WAIT_V(0);
    if constexpr (!ALIGN_EPI) { if (wr == 0) PG8_BAR; }
    PG8_BAR;
    if constexpr (Epi::AFTER_DRAIN) { E.fused(acc, cur, wr, wc, fr, fq, lds, wid, lane); S.done(cur); }
#undef PG8_SA
#undef PG8_SB
#undef PG8_STAGE
#undef PG8_LDA
#undef PG8_LDB
#undef PG8_MMA
#undef PG8_WAIT_V
#undef PG8_WAIT_L
#undef PG8_BAR
#undef PG8_SCHED
}
}
#ifndef PG8_SP2
#define PG8_SP2 true
#endif
#ifndef PG8_ALIGN
#define PG8_ALIGN true
#endif
constexpr int NWAVES = 8;
#ifndef MK_N_LAUNCHES
#define MK_N_LAUNCHES 1
#endif
constexpr int N_PHASES = 10;
constexpr int N_LAUNCHES = MK_N_LAUNCHES;

constexpr int BATCH = 8, SEQ = 2048, DM = 2048, M = BATCH * SEQ;
constexpr int NH = 8, HD = 128, AW = 1024, MBLK = 256, NBLK = SEQ / MBLK;
constexpr int DFF = 5632, PLED = 256, INW = 11264;
constexpr float NORM_EPS = 1e-6f;

constexpr size_t MiB = 1u << 20;
constexpr size_t WS_CTL = 0, CTL_ZERO_BYTES = 1 * MiB;
constexpr size_t WS_RSTD0 = 1 * MiB, WS_LB = WS_RSTD0 + 65536, WS_TB = WS_LB + 4096, WS_KMEAN = WS_RSTD0 + 131072;
constexpr size_t WS_SS1 = 2 * MiB, WS_SS3 = 4 * MiB;
constexpr size_t WS_WIN = 8 * MiB, WS_WGU = 52 * MiB, WS_WDN = 96 * MiB, WS_WOUT = 118 * MiB, WS_WPG = 126 * MiB, WS_WA = 134 * MiB, WS_WB = 138 * MiB, WS_WPLE = 142 * MiB;
constexpr size_t WS_PB = 143 * MiB;
constexpr size_t WS_RA = 152 * MiB;
constexpr size_t WS_Q = 216 * MiB, WS_K = 248 * MiB, WS_V = 280 * MiB, WS_QB = 312 * MiB, WS_F = 344 * MiB, WS_IB = 408 * MiB, WS_SG = 440 * MiB, WS_YB = 472 * MiB;
constexpr size_t WS_X1B = 248 * MiB, WS_ACT = 312 * MiB, WS_PLE = 216 * MiB, WS_END = 504 * MiB;
static_assert(WS_ACT + (size_t)M * DFF * 2 <= WS_END && WS_X1B + (size_t)M * DM * 2 <= WS_ACT && WS_PLE + (size_t)M * DM * 2 <= WS_ACT, "d_ws map");
constexpr int CW_BAR = 4096;

constexpr int RING_OFF = 0, RING_BYTES = 131072;
constexpr int LDSCTL_OFF = RING_BYTES, MISC_OFF = LDSCTL_OFF + 320, TAB_OFF = LDSCTL_OFF + 1024;
constexpr int LDS_BYTES = 147456;
static_assert(TAB_OFF + 1024 <= LDS_BYTES, "LDS map");
#define GAS __attribute__((address_space(1)))
#define LAS __attribute__((address_space(3)))
typedef unsigned short bf16;
typedef unsigned v4u __attribute__((ext_vector_type(4)));
typedef float f32x4 __attribute__((ext_vector_type(4)));
typedef short bf16x8 __attribute__((ext_vector_type(8)));
typedef GAS unsigned gu32;
typedef GAS unsigned long long gu64;
#define RLX_AGENT __ATOMIC_RELAXED, __HIP_MEMORY_SCOPE_AGENT
#define LDS_WAIT() asm volatile("s_waitcnt lgkmcnt(0)" ::: "memory")
#define VM_WAIT() asm volatile("s_waitcnt vmcnt(0)" ::: "memory")
__device__ __forceinline__ unsigned long long rt() { return __builtin_amdgcn_s_memrealtime(); }
__device__ __forceinline__ unsigned f2bf(float f) { unsigned u = __builtin_bit_cast(unsigned, f); return (u + 0x7fffu + ((u >> 16) & 1u)) >> 16; }
__device__ __forceinline__ unsigned pk2(float lo, float hi) { return f2bf(lo) | (f2bf(hi) << 16); }

#define XB_TMO      128
#define XB_XCNT(j)  (256  + 64 * (j))
#define XB_XSUB(j)  (1280 + 64 * (j))
#define XB_XGEN(j)  (2304 + 64 * (j))
#define XB_TOP      3328
#define XB_TOPGEN   3392
#define XCD_BAR_WORDS 3456
#define XB_SPIN_CAP (1u << 18)

__device__ __forceinline__ unsigned xb_ld(unsigned* p)              { return __hip_atomic_load(p, __ATOMIC_RELAXED, __HIP_MEMORY_SCOPE_AGENT); }
__device__ __forceinline__ unsigned xb_add(unsigned* p, unsigned v) { return __hip_atomic_fetch_add(p, v, __ATOMIC_RELAXED, __HIP_MEMORY_SCOPE_AGENT); }
__device__ __forceinline__ unsigned xb_xcc_id() { return (unsigned)__builtin_amdgcn_s_getreg((3 << 11) | 20) & 0xFu; }
#define XB_SPIN(cond, bar) do { unsigned _sp = 0; while (cond) { __builtin_amdgcn_s_sleep(1); \
    if ((++_sp & 255u) == 0u) { if (xb_ld(&(bar)[XB_TMO])) break; if (_sp > XB_SPIN_CAP) { atomicAdd(&(bar)[XB_TMO], 1u); break; } } } } while (0)

struct XcdBarrier {
    unsigned* bar; unsigned x;
    volatile LAS unsigned* st;
};

__device__ __forceinline__ XcdBarrier xcd_barrier_post(unsigned* bar, volatile LAS unsigned* st) {
    XcdBarrier b; b.bar = bar; b.x = xb_xcc_id(); b.st = st;
    if (threadIdx.x == 0) (void)xb_add(&bar[XB_XCNT(b.x)], 1u);
    return b;
}
__device__ __forceinline__ void xcd_barrier_complete(unsigned* bar, unsigned x, unsigned& nloc, unsigned& nx) {
    const unsigned G = gridDim.x * gridDim.y * gridDim.z;
    unsigned sum, cnt, mine, sp = 0u;
    for (;;) {
        sum = 0u; cnt = 0u; mine = 0u;
#pragma unroll
        for (unsigned j = 0; j < 16; ++j) { const unsigned c = xb_ld(&bar[XB_XCNT(j)]); sum += c; cnt += (c > 0u) ? 1u : 0u; mine = (j == x) ? c : mine; }
        if (sum == G) break;
        __builtin_amdgcn_s_sleep(1);
        if ((++sp & 255u) == 0u) { if (xb_ld(&bar[XB_TMO])) break; if (sp > XB_SPIN_CAP) { atomicAdd(&bar[XB_TMO], 1u); break; } }
    }
    nloc = mine > 0u ? mine : 1u; nx = cnt > 0u ? cnt : 1u;
}

__device__ __forceinline__ void xcd_barrier(const XcdBarrier& b) {
    asm volatile("s_waitcnt vmcnt(0)" ::: "memory");
    __syncthreads();
    if (threadIdx.x == 0) {
        unsigned* bar = b.bar;
        __builtin_amdgcn_s_waitcnt(0);
        unsigned nloc = b.st[0], nx = b.st[1];
        if (nloc == 0u) { xcd_barrier_complete(bar, b.x, nloc, nx); b.st[0] = nloc; b.st[1] = nx; }
        const unsigned old = xb_add(&bar[XB_XSUB(b.x)], 1u);
        const unsigned gen = old / nloc;
        if (old + 1u == (gen + 1u) * nloc) {
            __builtin_amdgcn_fence(__ATOMIC_RELEASE, "agent");
            asm volatile("s_waitcnt vmcnt(0)" ::: "memory");
            const unsigned og = xb_add(&bar[XB_TOP], 1u);
            const unsigned tg = og / nx;
            if (og + 1u == (tg + 1u) * nx) xb_add(&bar[XB_TOPGEN], 1u);
            else XB_SPIN(xb_ld(&bar[XB_TOPGEN]) == tg, bar);
            __builtin_amdgcn_fence(__ATOMIC_ACQUIRE, "agent");
            xb_add(&bar[XB_XGEN(b.x)], 1u);
            asm volatile("s_waitcnt vmcnt(0)" ::: "memory");
        } else {
            XB_SPIN(xb_ld(&bar[XB_XGEN(b.x)]) == gen, bar);
            __builtin_amdgcn_fence(__ATOMIC_ACQUIRE, "agent");
            asm volatile("s_waitcnt vmcnt(0)" ::: "memory");
        }
    }
    __syncthreads();
}
namespace att {
typedef short s16x4 __attribute__((ext_vector_type(4)));
typedef float f32x16 __attribute__((ext_vector_type(16)));
constexpr int PITCH = 1024, SHM_K = 16384, SHM_V = 16384;
constexpr int L_V = 0, L_K = 2 * SHM_V, L_WS = L_K + 2 * SHM_K, L_KM = L_WS + 8 * 256, L_SEL = L_KM + 4096, L_TB = L_SEL + 1024, L_END = L_TB + 1024;
constexpr float SCALE = 0.08838834764831845f;
#define KSWZ(row, colB) ((row) * 256 + ((colB) ^ (((row) & 7) << 4)))
#define SBAR() __builtin_amdgcn_sched_barrier(0)
__device__ __forceinline__ int v_st(int k, int c) { const int kk = (k & ~0xC) | ((k & 4) << 1) | ((k & 8) >> 1); return ((kk >> 3) * 4 + (c >> 5)) * 512 + ((kk & 7) * 32 + (c & 31)) * 2; }
__device__ __forceinline__ int v_rd_base(int lane) { return ((lane & 3) << 3) | (((lane >> 2) & 3) << 6) | (((lane >> 4) & 1) << 5) | (((lane >> 5) & 1) << 8); }
constexpr int v_rd_off(int d0, int ks, int half) { return d0 * 512 + ks * 4096 + half * 2048; }
__device__ __forceinline__ int crow(int r, int hi) { return (r & 3) + 8 * (r >> 2) + 4 * hi; }
__device__ __forceinline__ unsigned cvtpk(float lo, float hi) { unsigned r; asm volatile("v_cvt_pk_bf16_f32 %0, %1, %2" : "=v"(r) : "v"(lo), "v"(hi)); return r; }

__device__ __forceinline__ void partialSM(f32x16& p0, f32x16& p1, float& m_reg, float& mn, float& alpha) {
    float pmax = p0[0];
#pragma unroll
    for (int r = 1; r < 16; ++r) pmax = fmaxf(pmax, p0[r]);
#pragma unroll
    for (int r = 0; r < 16; ++r) pmax = fmaxf(pmax, p1[r]);
    { auto rr = __builtin_amdgcn_permlane32_swap(__float_as_uint(pmax), __float_as_uint(pmax), false, false);
      pmax = fmaxf(__uint_as_float(rr[0]), __uint_as_float(rr[1])); }
    constexpr float C2 = 1.4426950408889634f * SCALE;
    if (__all(pmax <= m_reg)) { mn = m_reg; alpha = 1.f; }
    else { mn = fmaxf(m_reg, pmax); alpha = __builtin_amdgcn_exp2f((m_reg - mn) * C2); m_reg = mn; }
    const float mnL = -mn * C2;
#pragma unroll
    for (int r = 0; r < 16; ++r) p0[r] = __builtin_amdgcn_exp2f(fmaf(p0[r], C2, mnL));
#pragma unroll
    for (int r = 0; r < 16; ++r) p1[r] = __builtin_amdgcn_exp2f(fmaf(p1[r], C2, mnL));
}
__device__ __forceinline__ void finishSM(f32x16& p0, f32x16& p1, float alpha, float& l_reg, bf16x8& pa0, bf16x8& pa1, bf16x8& pa2, bf16x8& pa3) {
    float ps = 0;
#pragma unroll
    for (int r = 0; r < 16; ++r) ps += p0[r];
#pragma unroll
    for (int r = 0; r < 16; ++r) ps += p1[r];
    { auto rr = __builtin_amdgcn_permlane32_swap(__float_as_uint(ps), __float_as_uint(ps), false, false);
      ps = __uint_as_float(rr[0]) + __uint_as_float(rr[1]); }
    l_reg = l_reg * alpha + ps;
#define PK4(P, B_, OUT) do { unsigned a0 = cvtpk(P[B_+0], P[B_+1]), a1 = cvtpk(P[B_+2], P[B_+3]);                          \
        unsigned b0 = cvtpk(P[B_+4], P[B_+5]), b1 = cvtpk(P[B_+6], P[B_+7]);                                             \
        auto r0 = __builtin_amdgcn_permlane32_swap(a0, b0, false, false); auto r1 = __builtin_amdgcn_permlane32_swap(a1, b1, false, false); \
        v4u w = {r0[0], r1[0], r0[1], r1[1]}; OUT = *reinterpret_cast<bf16x8*>(&w); } while (0)
    PK4(p0, 0, pa0); PK4(p0, 8, pa1); PK4(p1, 0, pa2); PK4(p1, 8, pa3);
#undef PK4
}
__device__ __forceinline__ void qkt(f32x16& p0, f32x16& p1, const LAS char* Kb, int r32, int hi, const bf16x8* qr) {
    p0 = f32x16{}; p1 = f32x16{};
    const LAS char* kb[4];
#pragma unroll
    for (int dd = 0; dd < 4; ++dd) kb[dd] = Kb + KSWZ(r32, (dd * 16 + hi * 8) * 2);
#pragma unroll
    for (int d0 = 0; d0 < 8; ++d0) { const LAS char* a = kb[d0 & 3] + (d0 >> 2) * 128;
        const bf16x8 b0 = *reinterpret_cast<const LAS bf16x8*>(a);
        const bf16x8 b1 = *reinterpret_cast<const LAS bf16x8*>(a + 32 * 256);
        p0 = __builtin_amdgcn_mfma_f32_32x32x16_bf16(b0, qr[d0], p0, 0, 0, 0);
        p1 = __builtin_amdgcn_mfma_f32_32x32x16_bf16(b1, qr[d0], p1, 0, 0, 0); }
}
__device__ __forceinline__ void pv_tile(f32x16* o, int vb0, bf16x8 pa0, bf16x8 pa1, bf16x8 pa2, bf16x8 pa3) {
#define TRRD(dst, off) asm volatile("ds_read_b64_tr_b16 %0, %1 offset:%2" : "=&v"(dst) : "v"(vb0), "i"(off) : "memory")
#define PV_D0(d0) do { s16x4 l0, l1, l2, l3, h0, h1, h2, h3; constexpr int b_ = v_rd_off(d0, 0, 0); \
        TRRD(l0, b_); TRRD(h0, b_ + 2048); TRRD(l1, b_ + 4096); TRRD(h1, b_ + 6144); TRRD(l2, b_ + 8192); TRRD(h2, b_ + 10240); TRRD(l3, b_ + 12288); TRRD(h3, b_ + 14336); \
        asm volatile("s_waitcnt lgkmcnt(0)" ::: "memory"); SBAR();   \
        o[d0] = __builtin_amdgcn_mfma_f32_32x32x16_bf16(pa0, (bf16x8){l0[0], l0[1], l0[2], l0[3], h0[0], h0[1], h0[2], h0[3]}, o[d0], 0, 0, 0);   \
        o[d0] = __builtin_amdgcn_mfma_f32_32x32x16_bf16(pa1, (bf16x8){l1[0], l1[1], l1[2], l1[3], h1[0], h1[1], h1[2], h1[3]}, o[d0], 0, 0, 0);   \
        o[d0] = __builtin_amdgcn_mfma_f32_32x32x16_bf16(pa2, (bf16x8){l2[0], l2[1], l2[2], l2[3], h2[0], h2[1], h2[2], h2[3]}, o[d0], 0, 0, 0);   \
        o[d0] = __builtin_amdgcn_mfma_f32_32x32x16_bf16(pa3, (bf16x8){l3[0], l3[1], l3[2], l3[3], h3[0], h3[1], h3[2], h3[3]}, o[d0], 0, 0, 0); } while (0)
    PV_D0(0); PV_D0(1); PV_D0(2); PV_D0(3);
#undef PV_D0
#undef TRRD
}
__device__ __forceinline__ void attn_unit(LAS char* lds, int b, int h, int qb, const bf16* Qg, const bf16* Kg, const bf16* Vg, bf16* Og, const float* kmean, const float* tbh) {
    int tid_ = threadIdx.x; asm volatile("" : "+v"(tid_));
    const int tid = tid_, wid = __builtin_amdgcn_readfirstlane(tid >> 6), lane = tid & 63, r32 = lane & 31, hi = lane >> 5;
    LAS char* V_lds = lds + L_V; LAS char* K_lds = lds + L_K;
    LAS float* wsf = (LAS float*)(lds + L_WS) + wid * 64; LAS float* li_l = wsf; LAS float* al_l = wsf + 32;
    LAS float* KM = (LAS float*)(lds + L_KM); LAS int* SEL = (LAS int*)(lds + L_SEL); LAS float* TB = (LAS float*)(lds + L_TB);
    const size_t rowbase = (size_t)b * SEQ;
    __syncthreads();
    if (tid < 256) *(LAS f32x4*)(KM + tid * 4) = *(const f32x4*)(kmean + (size_t)((b * NH + h) * NBLK) * HD + tid * 4);
    else if (tid < 256 + 129) TB[tid - 256] = tbh[tid - 256];
    __syncthreads();
    {
        const int row = tid >> 1, part = tid & 1;
        const bf16* qp = Qg + (rowbase + (size_t)qb * MBLK + row) * PITCH + h * HD;
        float a4[4] = {0.f, 0.f, 0.f, 0.f};
#pragma unroll 4
        for (int c = 0; c < 16; ++c) { const v4u qv = *(const v4u*)(qp + c * 8);
            const float q0 = __uint_as_float(qv.x << 16), q1 = __uint_as_float(qv.x & 0xffff0000u), q2 = __uint_as_float(qv.y << 16), q3 = __uint_as_float(qv.y & 0xffff0000u),
                        q4 = __uint_as_float(qv.z << 16), q5 = __uint_as_float(qv.z & 0xffff0000u), q6 = __uint_as_float(qv.w << 16), q7 = __uint_as_float(qv.w & 0xffff0000u);
#pragma unroll
            for (int nn = 0; nn < 4; ++nn) { const LAS float* km = KM + (2 * nn + part) * HD + c * 8; const f32x4 k0 = *(const LAS f32x4*)km, k1 = *(const LAS f32x4*)(km + 4);
                a4[nn] += (q0 * k0[0] + q1 * k0[1]) + (q2 * k0[2] + q3 * k0[3]) + (q4 * k1[0] + q5 * k1[1]) + (q6 * k1[2] + q7 * k1[3]); } }
        float sc[8];
#pragma unroll
        for (int nn = 0; nn < 4; ++nn) { const float ot = __shfl_xor(a4[nn], 1); sc[2 * nn] = part ? ot : a4[nn]; sc[2 * nn + 1] = part ? a4[nn] : ot; }
        int mask = 0;
        if (qb <= 3) mask = (1 << qb) - 1;
        else {
#pragma unroll
            for (int rd = 0; rd < 3; ++rd) { float best = -__builtin_inff(); int bi = 0;
#pragma unroll
                for (int n = 0; n < 8; ++n) { const bool ok = (n < qb) && !((mask >> n) & 1) && (sc[n] > best); best = ok ? sc[n] : best; bi = ok ? n : bi; }
                mask |= 1 << bi; } }
        if (part == 0) SEL[row] = mask;
    }
    bf16x8 qr[8];
    { const bf16* qp = Qg + (rowbase + (size_t)qb * MBLK + wid * 32 + r32) * PITCH + h * HD + hi * 8;
#pragma unroll
      for (int d0 = 0; d0 < 8; ++d0) qr[d0] = *(const bf16x8*)(qp + d0 * 16); }
    const int sr = tid >> 4, sc8 = (tid & 15) * 8, vst0 = v_st(sr, sc8), vst1 = v_st(32 + sr, sc8), kws = KSWZ(sr, sc8 * 2);
    const bf16* Kh = Kg + rowbase * PITCH + h * HD + sc8; const bf16* Vh = Vg + rowbase * PITCH + h * HD + sc8;
    bf16x8 st_k0, st_k1, st_v0, st_v1;
#define ATT_LOAD(kb) do { st_k0 = *(const bf16x8*)(Kh + (size_t)((kb) + sr) * PITCH); st_k1 = *(const bf16x8*)(Kh + (size_t)((kb) + 32 + sr) * PITCH); \
                          st_v0 = *(const bf16x8*)(Vh + (size_t)((kb) + sr) * PITCH); st_v1 = *(const bf16x8*)(Vh + (size_t)((kb) + 32 + sr) * PITCH); } while (0)
#define ATT_WRITE(bf) do { *(LAS bf16x8*)(K_lds + (bf) * SHM_K + kws) = st_k0; *(LAS bf16x8*)(K_lds + (bf) * SHM_K + kws + 32 * 256) = st_k1; \
                           *(LAS bf16x8*)(V_lds + (bf) * SHM_V + vst0) = st_v0; *(LAS bf16x8*)(V_lds + (bf) * SHM_V + vst1) = st_v1; } while (0)
    ATT_LOAD(0); ATT_WRITE(0);
    __syncthreads();
    const int selmask = SEL[wid * 32 + r32];
    const int qlo = qb * MBLK + wid * 32, qpos = qlo + r32;
    const int vbase = (int)(unsigned)(size_t)(V_lds) + v_rd_base(lane);
    float m_reg = -1e30f, l_reg = 0.f; f32x16 o[4] = {};
    const int T = 4 * (qb + 1);
    const float NEG = -__builtin_inff();
    for (int t = 0; t < T; ++t) {
        const int cur = t & 1, n = t >> 2, kbase = t * 64;
        if (t + 1 < T) ATT_LOAD(kbase + 64);
        const bool rowsel = (n == qb) || ((selmask >> n) & 1);
        const bool act = (n == qb) ? (kbase <= qlo + 31) : (__any(rowsel) != 0);
        if (act) {
            f32x16 p0, p1; float mn, alpha; bf16x8 pa0, pa1, pa2, pa3;
            qkt(p0, p1, K_lds + cur * SHM_K, r32, hi, qr);
            if (qlo - kbase - 63 < 128) {
                const int dq = qpos - kbase - 4 * hi;
#pragma unroll
                for (int r = 0; r < 16; ++r) { const int c = (r & 3) + 8 * (r >> 2); const int rel0 = dq - c, rel1 = rel0 - 32;
                    const int i0 = rel0 < 0 ? 0 : (rel0 > 128 ? 128 : rel0), i1 = rel1 < 0 ? 0 : (rel1 > 128 ? 128 : rel1);
                    const float v0 = p0[r] + TB[i0], v1 = p1[r] + TB[i1];
                    p0[r] = (rowsel && rel0 >= 0) ? v0 : NEG; p1[r] = (rowsel && rel1 >= 0) ? v1 : NEG;
                    if ((r & 3) == 3) asm volatile("" ::: "memory"); }
            } else {
#pragma unroll
                for (int r = 0; r < 16; ++r) { p0[r] = rowsel ? p0[r] : NEG; p1[r] = rowsel ? p1[r] : NEG; }
            }
            partialSM(p0, p1, m_reg, mn, alpha);
            if (__any(alpha < 1.f)) { if (hi == 0) al_l[r32] = alpha; asm volatile("s_waitcnt lgkmcnt(0)" ::: "memory");
#pragma unroll
                for (int d_ = 0; d_ < 4; ++d_)
#pragma unroll
                    for (int r = 0; r < 16; ++r) o[d_][r] *= al_l[crow(r, hi)]; }
            finishSM(p0, p1, alpha, l_reg, pa0, pa1, pa2, pa3);
            pv_tile(o, vbase + cur * SHM_V, pa0, pa1, pa2, pa3);
        }
        __syncthreads();
        if (t + 1 < T) ATT_WRITE(cur ^ 1);
        __syncthreads();
    }
#undef ATT_LOAD
#undef ATT_WRITE
    if (hi == 0) li_l[r32] = l_reg; asm volatile("s_waitcnt lgkmcnt(0)" ::: "memory");
    bf16* Ow = Og + (rowbase + (size_t)qb * MBLK + wid * 32) * PITCH + h * HD;
#pragma unroll
    for (int r = 0; r < 16; ++r) { const int orow = crow(r, hi); const float rl = __builtin_amdgcn_rcpf(li_l[orow]);
#pragma unroll
        for (int d0 = 0; d0 < 4; ++d0) { const float v = o[d0][r] * rl; const float vn = __shfl_xor(v, 1);
            if ((r32 & 1) == 0) *(unsigned*)(Ow + (size_t)orow * PITCH + d0 * 32 + r32) = cvtpk(v, vn); } }
}
#undef KSWZ
#undef SBAR
}
struct Frame {
    LAS unsigned char* lds;
    volatile LAS unsigned* MISC;
    gu32* ctl;
    int tid, lane, wave;
    int vcu, G;
    unsigned char* ws;
    const float* in[16];
    float* out;
};
__device__ __forceinline__ float wave_sum(float v) {
#pragma unroll
    for (int o = 1; o < 64; o <<= 1) v += __shfl_xor(v, o);
    return v;
}
__device__ const unsigned char k_t5b[128] = {0, 1, 2, 3, 4, 5, 6, 7, 8, 9, 10, 11, 12, 13, 14, 15, 16, 16, 16, 17, 17, 18, 18, 18, 19, 19, 19, 20, 20, 20, 20, 21, 21, 21, 21, 22, 22, 22, 22, 22, 23, 23, 23, 23, 23, 23,
    24, 24, 24, 24, 24, 24, 25, 25, 25, 25, 25, 25, 25, 26, 26, 26, 26, 26, 26, 26, 26, 27, 27, 27, 27, 27, 27, 27, 27, 27, 27, 28, 28, 28, 28, 28, 28, 28, 28, 28, 28, 29, 29, 29, 29, 29, 29, 29, 29, 29, 29, 29, 29,
    30, 30, 30, 30, 30, 30, 30, 30, 30, 30, 30, 30, 30, 30, 31, 31, 31, 31, 31, 31, 31, 31, 31, 31, 31, 31, 31, 31, 31};

__device__ __forceinline__ void p0_transpose_item(const float* W, int K, int N, bf16* WT, const float* gain, int mapmode, LAS float* scr, int item, int lane) {
    const int nblk = N / 32, kb = item / nblk, nb = item % nblk, k0 = 64 * kb, n0 = 32 * nb;
#pragma unroll 8
    for (int i = 0; i < 32; ++i) { const int kk = 2 * i + (lane >> 5); float v = W[(size_t)(k0 + kk) * N + n0 + (lane & 31)]; if (gain) v *= gain[k0 + kk]; scr[kk * 33 + (lane & 31)] = v; }
    LDS_WAIT(); asm volatile("" ::: "memory");
    int r0 = n0;
    if (mapmode == 1) { const int j = n0 < DFF ? n0 : n0 - DFF; r0 = 256 * (j >> 7) + (j & 127) + (n0 < DFF ? 0 : 128); }
    const int c = lane & 7;
#pragma unroll
    for (int j = 0; j < 4; ++j) { const int n = (lane >> 3) + 8 * j; const LAS float* s = scr + (8 * c) * 33 + n;
        v4u o; o.x = pk2(s[0 * 33], s[1 * 33]); o.y = pk2(s[2 * 33], s[3 * 33]); o.z = pk2(s[4 * 33], s[5 * 33]); o.w = pk2(s[6 * 33], s[7 * 33]);
        *(GAS v4u*)(WT + (size_t)(r0 + n) * K + k0 + 8 * c) = o; }
    LDS_WAIT(); asm volatile("" ::: "memory");
}
__device__ __forceinline__ void p0_prologue(Frame& F) {
    LAS float* scr = (LAS float*)(F.lds + RING_OFF + F.wave * 16384);
    const int gw = F.vcu * NWAVES + F.wave, NGW = F.G * NWAVES;
    bf16* Win_t = (bf16*)(F.ws + WS_WIN); bf16* Wgu_t = (bf16*)(F.ws + WS_WGU); bf16* Wdn_t = (bf16*)(F.ws + WS_WDN); bf16* Wout_t = (bf16*)(F.ws + WS_WOUT);
    bf16* Wpg_t = (bf16*)(F.ws + WS_WPG); bf16* Wa_t = (bf16*)(F.ws + WS_WA); bf16* Wb_t = (bf16*)(F.ws + WS_WB); bf16* Wple_t = (bf16*)(F.ws + WS_WPLE);
    constexpr int I_IN = (DM / 64) * (INW / 32), I_GU = (DM / 64) * (2 * DFF / 32), I_DN = (DFF / 64) * (DM / 32), I_SQ = (DM / 64) * (DM / 32), I_AB = (AW / 64) * (DM / 32), I_PLE = (PLED / 64) * (DM / 32);
    constexpr int NITEMS = I_IN + I_GU + I_DN + 2 * I_SQ + 2 * I_AB + I_PLE;
    for (int it = gw; it < NITEMS; it += NGW) {
        int r = it;
        if (r < I_IN) { p0_transpose_item(F.in[3], DM, INW, Win_t, F.in[2], 0, scr, r, F.lane); continue; } r -= I_IN;
        if (r < I_GU) { p0_transpose_item(F.in[9], DM, 2 * DFF, Wgu_t, F.in[8], 1, scr, r, F.lane); continue; } r -= I_GU;
        if (r < I_DN) { p0_transpose_item(F.in[10], DFF, DM, Wdn_t, nullptr, 0, scr, r, F.lane); continue; } r -= I_DN;
        if (r < I_SQ) { p0_transpose_item(F.in[7], DM, DM, Wout_t, nullptr, 0, scr, r, F.lane); continue; } r -= I_SQ;
        if (r < I_SQ) { p0_transpose_item(F.in[12], DM, DM, Wpg_t, nullptr, 0, scr, r, F.lane); continue; } r -= I_SQ;
        if (r < I_AB) { p0_transpose_item(F.in[5], AW, DM, Wa_t, nullptr, 0, scr, r, F.lane); continue; } r -= I_AB;
        if (r < I_AB) { p0_transpose_item(F.in[6], AW, DM, Wb_t, nullptr, 0, scr, r, F.lane); continue; } r -= I_AB;
        p0_transpose_item(F.in[11], PLED, DM, Wple_t, nullptr, 0, scr, r, F.lane);
    }
    { bf16* XB = (bf16*)(F.ws + WS_RA); float* rstd0 = (float*)(F.ws + WS_RSTD0); const float* x = F.in[0];
      for (int m = gw; m < M; m += NGW) { const GAS f32x4* xr = (const GAS f32x4*)(x + (size_t)m * DM) + F.lane; f32x4 v[8]; float s = 0.f;
#pragma unroll
          for (int j = 0; j < 8; ++j) { v[j] = xr[64 * j]; s += (v[j].x * v[j].x + v[j].y * v[j].y) + (v[j].z * v[j].z + v[j].w * v[j].w); }
          s = wave_sum(s); if (F.lane == 0) rstd0[m] = 1.0f / sqrtf(s * (1.0f / DM) + NORM_EPS);
          GAS unsigned long long* o8 = (GAS unsigned long long*)(XB + (size_t)m * DM) + F.lane;
#pragma unroll
          for (int j = 0; j < 8; ++j) o8[64 * j] = (unsigned long long)pk2(v[j].x, v[j].y) | ((unsigned long long)pk2(v[j].z, v[j].w) << 32); } }
    { bf16* PB = (bf16*)(F.ws + WS_PB); const GAS f32x4* p4 = (const GAS f32x4*)F.in[1]; GAS unsigned long long* o8 = (GAS unsigned long long*)PB;
      const int gt = gw * 64 + F.lane, NGT = NGW * 64;
      for (int i = gt; i < M * PLED / 4; i += NGT) { const f32x4 v = p4[i]; o8[i] = (unsigned long long)pk2(v.x, v.y) | ((unsigned long long)pk2(v.z, v.w) << 32); } }
    if (blockIdx.x == 0) { float* lb = (float*)(F.ws + WS_LB); const float* lg = F.in[14];
        for (int d = F.tid; d < AW; d += NWAVES * 64) lb[d] = 1.0f / (1.0f + expf(lg[AW + d] - lg[d])); }
    if (blockIdx.x == 1 || F.G == 1) { float* tb = (float*)(F.ws + WS_TB); const float* rb = F.in[13];
        for (int i = F.tid; i < NH * 129; i += NWAVES * 64) { const int h = i / 129, rel = i % 129; tb[i] = rel < 128 ? (rb[(int)k_t5b[rel] * NH + h] - rb[31 * NH + h]) * (1.0f / att::SCALE) : 0.f; } }
}
__device__ __forceinline__ void p2_kmean(Frame& F) {
    const bf16* Kb = (const bf16*)(F.ws + WS_K); float* kmean = (float*)(F.ws + WS_KMEAN);
    LAS float* red = (LAS float*)(F.lds + RING_OFF);
    const int cg = F.tid & 15, rg = F.tid >> 4;
    for (int it = F.vcu; it < BATCH * NBLK * NH; it += F.G) {
        const int h = it % NH, n = (it / NH) % NBLK, b = it / (NH * NBLK);
        const bf16* kp = Kb + ((size_t)b * SEQ + n * MBLK + rg * 8) * AW + h * HD + cg * 8;
        float s[8] = {0.f, 0.f, 0.f, 0.f, 0.f, 0.f, 0.f, 0.f};
#pragma unroll
        for (int r = 0; r < 8; ++r) { const v4u w = *(const GAS v4u*)(kp + (size_t)r * AW);
            s[0] += __uint_as_float(w.x << 16); s[1] += __uint_as_float(w.x & 0xffff0000u); s[2] += __uint_as_float(w.y << 16); s[3] += __uint_as_float(w.y & 0xffff0000u);
            s[4] += __uint_as_float(w.z << 16); s[5] += __uint_as_float(w.z & 0xffff0000u); s[6] += __uint_as_float(w.w << 16); s[7] += __uint_as_float(w.w & 0xffff0000u); }
        __syncthreads();
#pragma unroll
        for (int j = 0; j < 8; ++j) red[rg * 128 + cg * 8 + j] = s[j];
        __syncthreads();
        if (F.tid < 128) { float a = 0.f;
#pragma unroll 8
            for (int r = 0; r < 32; ++r) a += red[r * 128 + F.tid];
            kmean[(size_t)((b * NH + h) * NBLK + n) * HD + F.tid] = a * (1.0f / MBLK); }
    }
}
__device__ __forceinline__ void p2_hgrn_simple(Frame& F) {
    constexpr int TB_ = 16;
    const float* Fg = (const float*)(F.ws + WS_F); const bf16* QBg = (const bf16*)(F.ws + WS_QB); const bf16* IBg = (const bf16*)(F.ws + WS_IB); const bf16* SGg = (const bf16*)(F.ws + WS_SG);
    bf16* YB = (bf16*)(F.ws + WS_YB); const float* gain = F.in[4];
    LAS float* fS = (LAS float*)(F.lds + RING_OFF); LAS float* qS = fS + TB_ * 128; LAS float* iS = qS + TB_ * 128; LAS float* part = iS + TB_ * 128;
    const int vv = F.tid & 127, g = __builtin_amdgcn_readfirstlane(F.tid >> 7);
    for (int it = F.vcu; it < BATCH * NH; it += F.G) {
        const int b = it / NH, h = it % NH;
        float s[32];
#pragma unroll
        for (int j = 0; j < 32; ++j) s[j] = 0.f;
        for (int c0 = 0; c0 < SEQ; c0 += TB_) {
            __syncthreads();
#pragma unroll
            for (int e4 = 0; e4 < 4; ++e4) { const int e = F.tid + 512 * e4, tok = e >> 7, d = e & 127; const size_t gi = ((size_t)b * SEQ + c0 + tok) * AW + h * HD + d;
                fS[e] = Fg[gi]; qS[e] = __uint_as_float((unsigned)QBg[gi] << 16); iS[e] = __uint_as_float((unsigned)IBg[gi] << 16); }
            __syncthreads();
            for (int tok = 0; tok < TB_; ++tok) {
                const float iv = iS[tok * 128 + vv]; float acc = 0.f;
                const LAS f32x4* f4 = (const LAS f32x4*)(fS + tok * 128 + 32 * g); const LAS f32x4* q4 = (const LAS f32x4*)(qS + tok * 128 + 32 * g);
#pragma unroll
                for (int j4 = 0; j4 < 8; ++j4) { const f32x4 fv = f4[j4], qv = q4[j4];
#pragma unroll
                    for (int k = 0; k < 4; ++k) { const int j = 4 * j4 + k; s[j] = fmaf(fv[k], s[j] - iv, iv); acc = fmaf(s[j], qv[k], acc); } }
                part[(tok * 4 + g) * 128 + vv] = acc;
            }
            __syncthreads();
#pragma unroll
            for (int tt = 0; tt < 2; ++tt) { const int tok = 2 * F.wave + tt; float o2[2]; float ss = 0.f;
#pragma unroll
                for (int hf = 0; hf < 2; ++hf) { const int v2 = F.lane + 64 * hf; o2[hf] = (part[(tok * 4 + 0) * 128 + v2] + part[(tok * 4 + 1) * 128 + v2]) + (part[(tok * 4 + 2) * 128 + v2] + part[(tok * 4 + 3) * 128 + v2]); ss += o2[hf] * o2[hf]; }
                ss = wave_sum(ss); const float rstd = 1.0f / sqrtf(ss * (1.0f / HD) + NORM_EPS);
#pragma unroll
                for (int hf = 0; hf < 2; ++hf) { const int v2 = F.lane + 64 * hf; const size_t gi = ((size_t)b * SEQ + c0 + tok) * AW + h * HD + v2;
                    const float y = o2[hf] * rstd * gain[h * HD + v2] * __uint_as_float((unsigned)SGg[gi] << 16); YB[gi] = (bf16)f2bf(y); } }
        }
    }
}
__device__ __forceinline__ void p9_final(Frame& F) {
    const float* ssp = (const float*)(F.ws + WS_SS3); const float* gain = F.in[15];
    const int gw = F.vcu * NWAVES + F.wave, NGW = F.G * NWAVES;
    f32x4 gv[8];
#pragma unroll
    for (int j = 0; j < 8; ++j) gv[j] = *((const GAS f32x4*)gain + F.lane + 64 * j);
    for (int m = gw; m < M; m += NGW) {
        float s = F.lane < 32 ? ssp[(size_t)m * 32 + F.lane] : 0.f; s = wave_sum(s);
        const float rstd = 1.0f / sqrtf(s * (1.0f / DM) + NORM_EPS);
        GAS f32x4* xr = (GAS f32x4*)(F.out + (size_t)m * DM) + F.lane;
#pragma unroll
        for (int j = 0; j < 8; ++j) { f32x4 v = xr[64 * j]; v = v * rstd * gv[j]; xr[64 * j] = v; }
    }
}
__device__ __forceinline__ void build_rstd_tab(Frame& F, const float* ssp, int pm) {
    LAS float* tab = (LAS float*)(F.lds + TAB_OFF);
    const int row = F.tid >> 1, hf = F.tid & 1; const GAS f32x4* p = (const GAS f32x4*)(ssp + (size_t)(pm * 256 + row) * 32 + hf * 16);
    const f32x4 a = p[0], b = p[1], c = p[2], d = p[3];
    float s = ((a.x + a.y) + (a.z + a.w)) + ((b.x + b.y) + (b.z + b.w)) + ((c.x + c.y) + (c.z + c.w)) + ((d.x + d.y) + (d.z + d.w));
    const float o = __shfl_xor(s, 1); s = hf ? o + s : s + o;
    if (hf == 0) tab[row] = 1.0f / sqrtf(s * (1.0f / DM) + NORM_EPS);
    __syncthreads();
}

__device__ __forceinline__ void build_rstd0_tab(Frame& F, const float* rstd0, int pm) {
    LAS float* tab = (LAS float*)(F.lds + TAB_OFF);
    if (F.tid < 256) tab[F.tid] = rstd0[pm * 256 + F.tid];
    __syncthreads();
}
struct Args { const float* in[16]; float* out; unsigned char* ws; int ph_lo, ph_hi; };
__global__ void __launch_bounds__(NWAVES * 64, 2) mk_fwd(Args args) {
    extern __shared__ __attribute__((aligned(16))) unsigned char lds[];
    Frame F;
    F.lds = (LAS unsigned char*)lds;
    F.MISC = (volatile LAS unsigned*)(F.lds + MISC_OFF);
    F.tid = threadIdx.x; F.lane = F.tid & 63; F.wave = __builtin_amdgcn_readfirstlane(F.tid >> 6);
    F.G = gridDim.x; { const int bx = blockIdx.x; F.vcu = (F.G % 8 == 0) ? (bx % 8) * (F.G / 8) + bx / 8 : bx; }
    F.ws = args.ws; F.ctl = (gu32*)(args.ws + WS_CTL); F.out = args.out;
#pragma unroll
    for (int i = 0; i < 16; ++i) F.in[i] = args.in[i];
    for (int u = F.tid; u < (LDS_BYTES - LDSCTL_OFF) / 4; u += NWAVES * 64) ((LAS unsigned*)(F.lds + LDSCTL_OFF))[u] = 0u;
    __syncthreads();
    XcdBarrier bar; bar.bar = (unsigned*)(F.ctl + CW_BAR); bar.x = 0; bar.st = nullptr;
    if (N_LAUNCHES == 1) bar = xcd_barrier_post((unsigned*)(F.ctl + CW_BAR), F.MISC + 8);
#define GRID_BAR() do { if (N_LAUNCHES == 1) xcd_barrier(bar); } while (0)
    const int lo = args.ph_lo, hi = args.ph_hi;
#ifndef PH_MASK
#define PH_MASK 0x3ff
#endif
#define IN(k) (((PH_MASK >> (k)) & 1) && lo <= (k) && (k) < hi)
    unsigned char* ws = args.ws;
    bf16* XB = (bf16*)(ws + WS_RA); bf16* MIX = (bf16*)(ws + WS_RA); bf16* X2B = (bf16*)(ws + WS_RA);
    bf16* Qb = (bf16*)(ws + WS_Q); bf16* Kb = (bf16*)(ws + WS_K); bf16* Vb = (bf16*)(ws + WS_V); bf16* QBb = (bf16*)(ws + WS_QB); float* Fb = (float*)(ws + WS_F);
    bf16* IBb = (bf16*)(ws + WS_IB); bf16* SGb = (bf16*)(ws + WS_SG); bf16* YB = (bf16*)(ws + WS_YB); bf16* YA = Qb;
    bf16* GA = (bf16*)args.out; bf16* GB = GA + (size_t)M * DM;
    bf16* X1B = (bf16*)(ws + WS_X1B); bf16* ACT = (bf16*)(ws + WS_ACT); bf16* PLEb = (bf16*)(ws + WS_PLE); bf16* PB = (bf16*)(ws + WS_PB);
    const int c = (int)blockIdx.x;

    if (IN(0)) { p0_prologue(F); GRID_BAR(); }
    if (IN(1)) {
        pg8::Gemm g{XB, (const bf16*)(ws + WS_WIN), M, INW, DM}; pg8::StaticOrder S; S.init(M, INW, F.G, c);
        pg8::Unit u0; S.next(0, u0); build_rstd0_tab(F, (const float*)(ws + WS_RSTD0), u0.pm);
        pg8::EpiInProj E{Qb, Kb, Vb, QBb, IBb, SGb, GA, GB, Fb, (const PG8_LAS float*)(F.lds + TAB_OFF), (const float*)(ws + WS_LB)};
        pg8::gemm_phase<pg8::EpiInProj, pg8::StaticOrder, PG8_ALIGN, PG8_SP2>(F.lds + RING_OFF, g, S, E);
        GRID_BAR();
    }
    if (IN(2)) { p2_kmean(F); p2_hgrn_simple(F); GRID_BAR(); }
    if (IN(3)) {
        const float* kmean = (const float*)(ws + WS_KMEAN); const float* tb = (const float*)(ws + WS_TB);
        for (int v = F.vcu; v < BATCH * NH * 4; v += F.G) { const int bh = v >> 2, s = v & 3, b = bh / NH, h = bh % NH;
            _Pragma("nounroll") for (int pass = 0; pass < 2; ++pass) att::attn_unit((LAS char*)(F.lds + RING_OFF), b, h, pass ? s : 7 - s, Qb, Kb, Vb, YA, kmean, tb + h * 129); }
        GRID_BAR();
    }
    if (IN(4)) {
        { pg8::Gemm g{YA, (const bf16*)(ws + WS_WA), M, DM, AW}; pg8::StaticOrder S; S.init(M, DM, F.G, c); pg8::EpiMix<false> E{MIX, GA};
          pg8::gemm_phase<pg8::EpiMix<false>, pg8::StaticOrder, PG8_ALIGN, PG8_SP2>(F.lds + RING_OFF, g, S, E); }
        VM_WAIT(); __syncthreads();
        { pg8::Gemm g{YB, (const bf16*)(ws + WS_WB), M, DM, AW}; pg8::StaticOrder S; S.init(M, DM, F.G, c); pg8::EpiMix<true> E{MIX, GB};
          pg8::gemm_phase<pg8::EpiMix<true>, pg8::StaticOrder, PG8_ALIGN, PG8_SP2>(F.lds + RING_OFF, g, S, E); }
        GRID_BAR();
    }
    if (IN(5)) {
        pg8::Gemm g{MIX, (const bf16*)(ws + WS_WOUT), M, DM, DM}; pg8::StaticOrder S; S.init(M, DM, F.G, c);
        pg8::EpiResid<true> E{F.in[0], F.out, X1B, (float*)(ws + WS_SS1)};
        pg8::gemm_phase<pg8::EpiResid<true>, pg8::StaticOrder, PG8_ALIGN, PG8_SP2>(F.lds + RING_OFF, g, S, E);
        GRID_BAR();
    }
    if (IN(6)) {
        pg8::Gemm g{X1B, (const bf16*)(ws + WS_WGU), M, 2 * DFF, DM}; pg8::StaticOrder S; S.init(M, 2 * DFF, F.G, c);
        pg8::Unit u0; S.next(0, u0); build_rstd_tab(F, (const float*)(ws + WS_SS1), u0.pm);
        pg8::EpiGateUp E{ACT, (const PG8_LAS float*)(F.lds + TAB_OFF), DFF};
        pg8::gemm_phase<pg8::EpiGateUp, pg8::StaticOrder, PG8_ALIGN, PG8_SP2>(F.lds + RING_OFF, g, S, E);
        GRID_BAR();
    }
    if (IN(7)) {
        pg8::Gemm g{ACT, (const bf16*)(ws + WS_WDN), M, DM, DFF}; pg8::StaticOrder S; S.init(M, DM, F.G, c);
        pg8::EpiResid<false> E{F.out, F.out, X2B, nullptr};
        pg8::gemm_phase<pg8::EpiResid<false>, pg8::StaticOrder, PG8_ALIGN, PG8_SP2>(F.lds + RING_OFF, g, S, E);
        GRID_BAR();
    }
    if (IN(8)) {
        { pg8::Gemm g{PB, (const bf16*)(ws + WS_WPLE), M, DM, PLED}; pg8::StaticOrder S; S.init(M, DM, F.G, c); pg8::EpiPle E{PLEb};
          pg8::gemm_phase<pg8::EpiPle, pg8::StaticOrder, PG8_ALIGN, PG8_SP2>(F.lds + RING_OFF, g, S, E); }
        VM_WAIT(); __syncthreads();
        { pg8::Gemm g{X2B, (const bf16*)(ws + WS_WPG), M, DM, DM}; pg8::StaticOrder S; S.init(M, DM, F.G, c); pg8::EpiPleGate E{F.out, PLEb, (float*)(ws + WS_SS3)};
          pg8::gemm_phase<pg8::EpiPleGate, pg8::StaticOrder, PG8_ALIGN, PG8_SP2>(F.lds + RING_OFF, g, S, E); }
        GRID_BAR();
    }
    if (IN(9)) { p9_final(F); }
#undef IN
#undef GRID_BAR
}

extern "C" void kernel_launch(void* const* d_in, const int* in_sizes, int n_in, void* d_out, int out_size, void* d_ws, size_t ws_size, hipStream_t stream) {
    static int grid = 0;
    if (grid == 0) {
        if (n_in != 16 || in_sizes[0] != M * DM || out_size != M * DM || ws_size < WS_END) { fprintf(stderr, "kernel_launch: shape/workspace mismatch (n_in %d, in0 %d, out %d, ws %zu, need %zu); nothing launched\n", n_in, n_in > 0 ? in_sizes[0] : -1, out_size, ws_size, (size_t)WS_END); grid = -1; return; }
        int dev = 0, cus = 0, per_cu = 0;
        if (hipGetDevice(&dev) != hipSuccess || hipDeviceGetAttribute(&cus, hipDeviceAttributeMultiprocessorCount, dev) != hipSuccess) { fprintf(stderr, "kernel_launch: device query failed\n"); grid = -1; return; }
        if (hipFuncSetAttribute((const void*)mk_fwd, hipFuncAttributeMaxDynamicSharedMemorySize, LDS_BYTES) != hipSuccess) { fprintf(stderr, "kernel_launch: hipFuncSetAttribute failed\n"); grid = -1; return; }
        if (hipOccupancyMaxActiveBlocksPerMultiprocessor(&per_cu, (const void*)mk_fwd, NWAVES * 64, LDS_BYTES) != hipSuccess || per_cu < 1) { fprintf(stderr, "kernel_launch: occupancy query reports %d workgroups per CU\n", per_cu); }
        (void)hipGetLastError();
        grid = cus;
    }
    if (grid < 0) return;
    if (hipMemsetAsync((char*)d_ws + WS_CTL, 0, CTL_ZERO_BYTES, stream) != hipSuccess) { fprintf(stderr, "kernel_launch: memset failed\n"); return; }
    Args a{};
    for (int i = 0; i < 16; ++i) a.in[i] = (const float*)d_in[i];
    a.out = (float*)d_out; a.ws = (unsigned char*)d_ws;
    for (int li = 0; li < N_LAUNCHES; ++li) {
        a.ph_lo = (N_LAUNCHES == 1) ? 0 : li; a.ph_hi = (N_LAUNCHES == 1) ? N_PHASES : li + 1;
        hipLaunchKernelGGL(mk_fwd, dim3(grid), dim3(NWAVES * 64), LDS_BYTES, stream, a);
        const hipError_t le = hipPeekAtLastError();
        if (le != hipSuccess) { fprintf(stderr, "kernel_launch: launch %d failed: %s\n", li, hipGetErrorName(le)); break; }
    }
}
```

```cpp
#include <hip/hip_runtime.h>
#include <cstdio>
#include <cstdint>
namespace pg8 {
#define PG8_LAS __attribute__((address_space(3)))
typedef unsigned short bf16_t;
typedef short bf16x8 __attribute__((ext_vector_type(8)));
typedef float f32x4 __attribute__((ext_vector_type(4)));
typedef unsigned u32x4 __attribute__((ext_vector_type(4)));
constexpr int BM = 256, BK = 64, HALF = 128, HTB = HALF * BK * 2  , STAGE_BYTES = 8 * HTB, NXCD = 8, WGM = 8;

__host__ __device__ __forceinline__ int lds_byte(int r, int c) { const int st = (r >> 4) * 2 + (c >> 5), rr = r & 15, cc = c & 31, ob = rr * 64 + cc * 2; return st * 1024 + (ob ^ (((ob >> 9) & 1) << 5)); }
__host__ __device__ __forceinline__ void stage_rc(int b, int& R, int& C) { const int st = b / 1024, sb = b % 1024, swz = sb ^ (((sb >> 9) & 1) << 5); R = (st >> 1) * 16 + swz / 64; C = (st & 1) * 32 + (swz % 64) / 2; }
__host__ __device__ __forceinline__ int perm32(int rho) { const int n = rho >> 4, i = rho & 15; return 8 * (i >> 2) + 4 * n + (i & 3); }

struct Unit { int pm, pn; };
struct Gemm { const bf16_t* A; const bf16_t* Bt; int M, N, K; const bf16_t* A2; const bf16_t* Bt2; };

struct StaticOrder {
    int nM, nN, nwg, G, c;
    __host__ __device__ __forceinline__ void init(int M, int N, int G_, int c_) { nM = M / BM; nN = N / BM; nwg = nM * nN; G = G_; c = c_; }
    __host__ __device__ __forceinline__ bool next(int i, Unit& u) const {
        const long L = (long)i * G + c; if (L >= nwg) return false;
        int wgid = (int)L; { const int q = nwg / NXCD, r = nwg % NXCD, xcd = wgid % NXCD, off = wgid / NXCD; wgid = (xcd < r ? xcd * (q + 1) : r * (q + 1) + (xcd - r) * q) + off; }
        const int nig = WGM * nN, gid = wgid / nig, fm = gid * WGM, gsz = (nM - fm) < WGM ? (nM - fm) : WGM;
        u.pm = fm + ((wgid % nig) % gsz); u.pn = (wgid % nig) / gsz; return true;
    }
    __device__ __forceinline__ void a_ready(const Unit&) const {}
    __device__ __forceinline__ void done(const Unit&) const {}
};
__device__ __forceinline__ unsigned cvt_pk_bf16(float lo, float hi) { unsigned r; asm volatile("v_cvt_pk_bf16_f32 %0, %1, %2" : "=v"(r) : "v"(lo), "v"(hi)); return r; }
typedef float f32x2 __attribute__((ext_vector_type(2)));
__device__ __forceinline__ float sigm(float v) { return __builtin_amdgcn_rcpf(1.0f + __expf(-v)); }
__device__ __forceinline__ float bf_lo(unsigned w) { return __uint_as_float(w << 16); }
__device__ __forceinline__ float bf_hi(unsigned w) { return __uint_as_float(w & 0xffff0000u); }
__device__ __forceinline__ u32x4 pack8(f32x4 v0, f32x4 v1) { u32x4 w; w.x = cvt_pk_bf16(v0[0], v0[1]); w.y = cvt_pk_bf16(v0[2], v0[3]); w.z = cvt_pk_bf16(v1[0], v1[1]); w.w = cvt_pk_bf16(v1[2], v1[3]); return w; }
typedef unsigned u32x2 __attribute__((ext_vector_type(2)));
__device__ __forceinline__ f32x4 sig4(f32x4 a, float rneg) { f32x4 t = a * rneg, e; e[0] = __builtin_amdgcn_exp2f(t[0]); e[1] = __builtin_amdgcn_exp2f(t[1]); e[2] = __builtin_amdgcn_exp2f(t[2]); e[3] = __builtin_amdgcn_exp2f(t[3]);
    e = e + 1.0f; f32x4 o; o[0] = __builtin_amdgcn_rcpf(e[0]); o[1] = __builtin_amdgcn_rcpf(e[1]); o[2] = __builtin_amdgcn_rcpf(e[2]); o[3] = __builtin_amdgcn_rcpf(e[3]); return o; }

struct EpiInProj {
    static constexpr bool PERM = true, AFTER_DRAIN = false; static constexpr int SEAM_VMOPS = 16;
    bf16_t *Q, *K, *V, *QB, *IB, *SG, *GA, *GB; float* F; const PG8_LAS float* tab; const float* lb; float* KMP;
    __device__ __forceinline__ void operator()(const f32x4 (&acc)[2][2][4][2], const Unit& u, int wr, int wc, int fr, int fq) const {
        const int seg = u.pn >> 2; const int rl0 = wr * 64 + fr, row0 = u.pm * BM + rl0;
        int mode = 0, ldc = 1024, colt = (u.pn & 3) * 256; bf16_t* ob = Q;
        if (seg == 1) ob = K; else if (seg == 2) ob = V; else if (seg == 3) ob = QB; else if (seg == 4) mode = 1; else if (seg == 5) ob = IB; else if (seg == 6) { ob = SG; mode = 2; }
        else if (seg == 7 || seg == 8) { ob = GA; mode = 3; ldc = 2048; colt = (u.pn - 28) * 256; } else if (seg >= 9) { ob = GB; mode = 3; ldc = 2048; colt = (u.pn - 36) * 256; }
        const int col0 = colt + wc * 32 + 8 * fq;
        if (mode == 1) {
            f32x4 lbv[2][2];
#pragma unroll
            for (int bj = 0; bj < 2; ++bj)
#pragma unroll
                for (int n = 0; n < 2; ++n) lbv[bj][n] = *(const f32x4*)(lb + col0 + bj * HALF + 4 * n);
#pragma unroll
            for (int ai = 0; ai < 2; ++ai)
#pragma unroll
                for (int m = 0; m < 4; ++m) { const int row = row0 + ai * HALF + m * 16; const float r = tab[rl0 + ai * HALF + m * 16]; float* rowp = F + (size_t)row * 1024 + col0;
#pragma unroll
                    for (int bj = 0; bj < 2; ++bj)
#pragma unroll
                        for (int n = 0; n < 2; ++n) { const f32x4 l = lbv[bj][n]; const f32x4 o = l + (1.0f - l) * sig4(acc[ai][bj][m][n], r * -1.4426950408889634f);
                            *(f32x4*)(rowp + bj * HALF + 4 * n) = o; } }
        } else {
            if (seg == 1) {
                f32x4 cs[2][2];
#pragma unroll
                for (int bj = 0; bj < 2; ++bj)
#pragma unroll
                    for (int n = 0; n < 2; ++n) { f32x4 s = {0.f, 0.f, 0.f, 0.f};
#pragma unroll
                        for (int ai = 0; ai < 2; ++ai)
#pragma unroll
                            for (int m = 0; m < 4; ++m) s += acc[ai][bj][m][n] * tab[rl0 + ai * HALF + m * 16];
#pragma unroll
                        for (int o = 1; o < 16; o <<= 1) { s[0] += __shfl_xor(s[0], o); s[1] += __shfl_xor(s[1], o); s[2] += __shfl_xor(s[2], o); s[3] += __shfl_xor(s[3], o); }
                        cs[bj][n] = s; }
                if (fr == 0) {
#pragma unroll
                    for (int bj = 0; bj < 2; ++bj)
#pragma unroll
                        for (int n = 0; n < 2; ++n) *(f32x4*)(KMP + ((size_t)(((u.pm >> 3) * 8 + (2 * (u.pn & 3) + bj)) * 8 + (u.pm & 7)) * 2 + wr) * 128 + wc * 32 + 8 * fq + 4 * n) = cs[bj][n]; }
            }
#pragma unroll
            for (int ai = 0; ai < 2; ++ai)
#pragma unroll
                for (int m = 0; m < 4; ++m) { const int row = row0 + ai * HALF + m * 16; const float r = tab[rl0 + ai * HALF + m * 16]; bf16_t* rowp = ob + (size_t)row * ldc + col0;
#pragma unroll
                    for (int bj = 0; bj < 2; ++bj) { f32x4 v0, v1; const float rneg = r * -1.4426950408889634f;
                        if (mode == 3) { v0 = sig4(acc[ai][bj][m][0], rneg); v1 = sig4(acc[ai][bj][m][1], rneg); }
                        else { v0 = acc[ai][bj][m][0] * r; v1 = acc[ai][bj][m][1] * r; if (mode == 2) { v0 = v0 * sig4(acc[ai][bj][m][0], rneg); v1 = v1 * sig4(acc[ai][bj][m][1], rneg); } }
                        *(u32x4*)(rowp + bj * HALF) = pack8(v0, v1); } }
        }
    }
};
struct EpiMix2 {
    static constexpr bool PERM = true, AFTER_DRAIN = false; static constexpr int SEAM_VMOPS = 16;
    bf16_t* MIX; const bf16_t* GA; const bf16_t* GB;
    __device__ __forceinline__ void mid(f32x4 (&acc)[2][2][4][2], const Unit& u, int wr, int wc, int fr, int fq) const {
        const int row0 = u.pm * BM + wr * 64 + fr, col0 = u.pn * BM + wc * 32 + 8 * fq;
        u32x4 ga[2][2][2], gb[2][2][2];
#define MX_LOAD(q) do { _Pragma("unroll") for (int m2 = 0; m2 < 2; ++m2) _Pragma("unroll") for (int bj = 0; bj < 2; ++bj) { const size_t off = (size_t)(row0 + ((q) >> 1) * HALF + (2 * ((q) & 1) + m2) * 16) * 2048 + col0 + bj * HALF; \
            ga[(q) & 1][m2][bj] = *(const u32x4*)(GA + off); gb[(q) & 1][m2][bj] = *(const u32x4*)(GB + off); } } while (0)
#define MX_COMP(q) do { _Pragma("unroll") for (int m2 = 0; m2 < 2; ++m2) _Pragma("unroll") for (int bj = 0; bj < 2; ++bj) { const u32x4 a = ga[(q) & 1][m2][bj], b = gb[(q) & 1][m2][bj]; \
            f32x4& v0 = acc[(q) >> 1][bj][2 * ((q) & 1) + m2][0]; f32x4& v1 = acc[(q) >> 1][bj][2 * ((q) & 1) + m2][1]; \
            v0[0] *= bf_lo(a.x) * __builtin_amdgcn_rcpf(bf_lo(b.x)); v0[1] *= bf_hi(a.x) * __builtin_amdgcn_rcpf(bf_hi(b.x)); v0[2] *= bf_lo(a.y) * __builtin_amdgcn_rcpf(bf_lo(b.y)); v0[3] *= bf_hi(a.y) * __builtin_amdgcn_rcpf(bf_hi(b.y)); \
            v1[0] *= bf_lo(a.z) * __builtin_amdgcn_rcpf(bf_lo(b.z)); v1[1] *= bf_hi(a.z) * __builtin_amdgcn_rcpf(bf_hi(b.z)); v1[2] *= bf_lo(a.w) * __builtin_amdgcn_rcpf(bf_lo(b.w)); v1[3] *= bf_hi(a.w) * __builtin_amdgcn_rcpf(bf_hi(b.w)); } } while (0)
        MX_LOAD(0); MX_LOAD(1);
        MX_COMP(0); asm volatile("" ::: "memory"); MX_LOAD(2);
        MX_COMP(1); asm volatile("" ::: "memory"); MX_LOAD(3);
        MX_COMP(2); asm volatile("" ::: "memory");
        MX_COMP(3); asm volatile("" ::: "memory");
#undef MX_LOAD
#undef MX_COMP
    }
    __device__ __forceinline__ void operator()(const f32x4 (&acc)[2][2][4][2], const Unit& u, int wr, int wc, int fr, int fq) const {
        const int row0 = u.pm * BM + wr * 64 + fr, col0 = u.pn * BM + wc * 32 + 8 * fq;
        u32x4 gb[2][4][2];
#pragma unroll
        for (int ai = 0; ai < 2; ++ai)
#pragma unroll
            for (int m = 0; m < 4; ++m)
#pragma unroll
                for (int bj = 0; bj < 2; ++bj) gb[ai][m][bj] = *(const u32x4*)(GB + (size_t)(row0 + ai * HALF + m * 16) * 2048 + col0 + bj * HALF);
#pragma unroll
        for (int ai = 0; ai < 2; ++ai)
#pragma unroll
            for (int m = 0; m < 4; ++m)
#pragma unroll
                for (int bj = 0; bj < 2; ++bj) { const u32x4 g = gb[ai][m][bj]; f32x4 v0 = acc[ai][bj][m][0], v1 = acc[ai][bj][m][1];
                    v0[0] *= bf_lo(g.x); v0[1] *= bf_hi(g.x); v0[2] *= bf_lo(g.y); v0[3] *= bf_hi(g.y); v1[0] *= bf_lo(g.z); v1[1] *= bf_hi(g.z); v1[2] *= bf_lo(g.w); v1[3] *= bf_hi(g.w);
                    *(u32x4*)(MIX + (size_t)(row0 + ai * HALF + m * 16) * 2048 + col0 + bj * HALF) = pack8(v0, v1); }
        asm volatile("" ::: "memory");
    }
};
template <bool SS> struct EpiResid {
    static constexpr bool PERM = true, AFTER_DRAIN = false; static constexpr int SEAM_VMOPS = 16;
    const bf16_t* XI; bf16_t* XO; float* SSP;
    __device__ __forceinline__ void operator()(const f32x4 (&acc)[2][2][4][2], const Unit& u, int wr, int wc, int fr, int fq) const {
        const int row0 = u.pm * BM + wr * 64 + fr, col0 = u.pn * BM + wc * 32 + 8 * fq;
        u32x4 xin[2][4][2];
#pragma unroll
        for (int ai = 0; ai < 2; ++ai)
#pragma unroll
            for (int m = 0; m < 4; ++m)
#pragma unroll
                for (int bj = 0; bj < 2; ++bj) xin[ai][m][bj] = *(const u32x4*)(XI + (size_t)(row0 + ai * HALF + m * 16) * 2048 + col0 + bj * HALF);
#pragma unroll
        for (int ai = 0; ai < 2; ++ai)
#pragma unroll
            for (int m = 0; m < 4; ++m) { const int row = row0 + ai * HALF + m * 16; const size_t off = (size_t)row * 2048 + col0; float s = 0.f;
#pragma unroll
                for (int bj = 0; bj < 2; ++bj) { const u32x4 xi = xin[ai][m][bj]; f32x4 o0 = acc[ai][bj][m][0], o1 = acc[ai][bj][m][1];
                    o0[0] += bf_lo(xi.x); o0[1] += bf_hi(xi.x); o0[2] += bf_lo(xi.y); o0[3] += bf_hi(xi.y); o1[0] += bf_lo(xi.z); o1[1] += bf_hi(xi.z); o1[2] += bf_lo(xi.w); o1[3] += bf_hi(xi.w);
                    s += ((o0[0] * o0[0] + o0[1] * o0[1]) + (o0[2] * o0[2] + o0[3] * o0[3])) + ((o1[0] * o1[0] + o1[1] * o1[1]) + (o1[2] * o1[2] + o1[3] * o1[3]));
                    *(u32x4*)(XO + off + bj * HALF) = pack8(o0, o1); }
                if (SS) { s += __shfl_xor(s, 16); s += __shfl_xor(s, 32); if (fq == 0) SSP[(size_t)row * 32 + u.pn * 4 + wc] = s; } }
        asm volatile("" ::: "memory");
    }
};
struct EpiGateUp {
    static constexpr bool PERM = true, AFTER_DRAIN = false; static constexpr int SEAM_VMOPS = 8;
    bf16_t* ACT; const PG8_LAS float* tab; int ldc;
    __device__ __forceinline__ void operator()(const f32x4 (&acc)[2][2][4][2], const Unit& u, int wr, int wc, int fr, int fq) const {
        const int col0 = u.pn * 128 + wc * 32 + 8 * fq;
#pragma unroll
        for (int ai = 0; ai < 2; ++ai)
#pragma unroll
            for (int m = 0; m < 4; ++m) { const int rl = ai * HALF + wr * 64 + m * 16 + fr; const float r = tab[rl];
                f32x4 a0, a1;
#pragma unroll
                for (int j = 0; j < 4; ++j) { a0[j] = 0.f; a1[j] = 0.f; }
                { const float rneg = r * -1.4426950408889634f, r2 = r * r;
                  a0 = (acc[ai][0][m][0] * acc[ai][1][m][0]) * r2 * sig4(acc[ai][0][m][0], rneg); a1 = (acc[ai][0][m][1] * acc[ai][1][m][1]) * r2 * sig4(acc[ai][0][m][1], rneg); }
                *(u32x4*)(ACT + (size_t)(u.pm * BM + rl) * ldc + col0) = pack8(a0, a1); }
    }
};
struct EpiPle {
    static constexpr bool PERM = true, AFTER_DRAIN = false; static constexpr int SEAM_VMOPS = 0;
    bf16_t* O;
    __device__ __forceinline__ void operator()(const f32x4 (&acc)[2][2][4][2], const Unit& u, int wr, int wc, int fr, int fq) const {
        const int row0 = u.pm * BM + wr * 64 + fr, col0 = u.pn * BM + wc * 32 + 8 * fq;
#pragma unroll
        for (int ai = 0; ai < 2; ++ai)
#pragma unroll
            for (int m = 0; m < 4; ++m)
#pragma unroll
                for (int bj = 0; bj < 2; ++bj) *(u32x4*)(O + (size_t)(row0 + ai * HALF + m * 16) * 2048 + col0 + bj * HALF) = pack8(acc[ai][bj][m][0], acc[ai][bj][m][1]);
    }
};
struct EpiPleGate {
    static constexpr bool PERM = true, AFTER_DRAIN = false; static constexpr int SEAM_VMOPS = 8;
    const bf16_t* XI; bf16_t* XO; const bf16_t* PLE; float* SSP;
    __device__ __forceinline__ void operator()(const f32x4 (&acc)[2][2][4][2], const Unit& u, int wr, int wc, int fr, int fq) const {
        const int row0 = u.pm * BM + wr * 64 + fr, col0 = u.pn * BM + wc * 32 + 8 * fq;
        u32x4 xin[2][2][2], pin[2][2][2];
#define PGT_LOAD(q) do { _Pragma("unroll") for (int m2 = 0; m2 < 2; ++m2) _Pragma("unroll") for (int bj = 0; bj < 2; ++bj) { const unsigned o_ = (unsigned)(row0 + ((q) >> 1) * HALF + (2 * ((q) & 1) + m2) * 16) * 2048u + (unsigned)(col0 + bj * HALF); \
            xin[(q) & 1][m2][bj] = *(const u32x4*)(XI + o_); pin[(q) & 1][m2][bj] = *(const u32x4*)(PLE + o_); } } while (0)
#define PGT_E(av, xw, pw, lo) ((lo ? bf_lo(xw) : bf_hi(xw)) + sigm(av) * (lo ? bf_lo(pw) : bf_hi(pw)))
#define PGT_COMP(q) do { _Pragma("unroll") for (int m2 = 0; m2 < 2; ++m2) { const int m = 2 * ((q) & 1) + m2; const int row = row0 + ((q) >> 1) * HALF + m * 16; const unsigned off = (unsigned)row * 2048u + (unsigned)col0; float s = 0.f; \
            _Pragma("unroll") for (int bj = 0; bj < 2; ++bj) { const f32x4 a0 = acc[(q) >> 1][bj][m][0], a1 = acc[(q) >> 1][bj][m][1]; const u32x4 xi = xin[(q) & 1][m2][bj], pl = pin[(q) & 1][m2][bj]; f32x4 o0, o1; \
                o0[0] = PGT_E(a0[0], xi.x, pl.x, true); o0[1] = PGT_E(a0[1], xi.x, pl.x, false); o0[2] = PGT_E(a0[2], xi.y, pl.y, true); o0[3] = PGT_E(a0[3], xi.y, pl.y, false); \
                o1[0] = PGT_E(a1[0], xi.z, pl.z, true); o1[1] = PGT_E(a1[1], xi.z, pl.z, false); o1[2] = PGT_E(a1[2], xi.w, pl.w, true); o1[3] = PGT_E(a1[3], xi.w, pl.w, false); \
                s += ((o0[0] * o0[0] + o0[1] * o0[1]) + (o0[2] * o0[2] + o0[3] * o0[3])) + ((o1[0] * o1[0] + o1[1] * o1[1]) + (o1[2] * o1[2] + o1[3] * o1[3])); \
                *(u32x4*)(XO + off + bj * HALF) = pack8(o0, o1); } \
            s += __shfl_xor(s, 16); s += __shfl_xor(s, 32); if (fq == 0) SSP[(size_t)row * 32 + u.pn * 4 + wc] = s; } } while (0)
        PGT_LOAD(0); PGT_LOAD(1);
        PGT_COMP(0); asm volatile("" ::: "memory"); PGT_LOAD(2);
        PGT_COMP(1); asm volatile("" ::: "memory"); PGT_LOAD(3);
        PGT_COMP(2); asm volatile("" ::: "memory");
        PGT_COMP(3); asm volatile("" ::: "memory");
#undef PGT_LOAD
#undef PGT_E
#undef PGT_COMP
    }
};

struct EpiNull {
    static constexpr bool PERM = true, AFTER_DRAIN = false; static constexpr int SEAM_VMOPS = 0;
    __device__ __forceinline__ void operator()(const f32x4 (&acc)[2][2][4][2], const Unit& u, int wr, int wc, int fr, int fq) const {
#pragma unroll
        for (int ai = 0; ai < 2; ++ai)
#pragma unroll
            for (int bj = 0; bj < 2; ++bj)
#pragma unroll
                for (int m = 0; m < 4; ++m)
#pragma unroll
                    for (int n = 0; n < 2; ++n) asm volatile("" :: "v"(acc[ai][bj][m][n]));
    }
};
struct SameTileOrder { int n; __device__ __forceinline__ bool next(int i, Unit& u) const { if (i >= n) return false; u.pm = 0; u.pn = 0; return true; }
    __device__ __forceinline__ void a_ready(const Unit&) const {} __device__ __forceinline__ void done(const Unit&) const {} };
template <class Epi, class Sched, bool ALIGN_EPI = false, bool SP2 = false, bool DUAL = false>
__device__ __forceinline__ void gemm_phase(PG8_LAS unsigned char* lds, const Gemm g, const Sched& S, const Epi& E) {
    int tid_ = threadIdx.x; asm volatile("" : "+v"(tid_));
    const int tid = tid_, wid = __builtin_amdgcn_readfirstlane(tid >> 6), lane = tid & 63, wr = wid >> 2, wc = wid & 3, fr = lane & 15, fq = lane >> 4;
    const int K = g.K, nt = K / BK;
    unsigned voffA[2], voffB[2];
#pragma unroll
    for (int i = 0; i < 2; ++i) { int R, C; stage_rc(tid * 16 + i * 8192, R, C); const int Rb = Epi::PERM ? ((R & ~31) + perm32(R & 31)) : R;
        voffA[i] = (unsigned)(R * K + C) * 2u; voffB[i] = (unsigned)(Rb * K + C) * 2u; }
    const size_t kstep = (size_t)(BK * 2);
    const size_t hstep = (size_t)HALF * K * 2;
    const size_t tstep = 2 * hstep;
    const unsigned ldsw = (unsigned)wid * 1024u;
    const int aoff = lds_byte(wr * 64 + fr, fq * 8), boff = lds_byte(wc * 32 + fr, fq * 8);
#define PG8_SA(b, h) (((b) * 2 + (h)) * HTB)
#define PG8_SB(b, h) ((4 + (b) * 2 + (h)) * HTB)
#define PG8_STAGE(bufoff, gbase, voff) do { _Pragma("unroll") for (int _i = 0; _i < 2; ++_i) \
        __builtin_amdgcn_global_load_lds((const unsigned*)((const char*)(gbase) + (voff)[_i]), (PG8_LAS unsigned*)(lds + (bufoff) + ldsw + _i * 8192), 16, 0, 0); } while (0)
#define PG8_LDA(dst, b, h) do { _Pragma("unroll") for (int m = 0; m < 4; ++m) _Pragma("unroll") for (int k = 0; k < 2; ++k) dst[m][k] = *(const PG8_LAS bf16x8*)(lds + PG8_SA(b, h) + aoff + m * 2048 + k * 1024); } while (0)
#define PG8_LDB(dst, b, h) do { _Pragma("unroll") for (int n = 0; n < 2; ++n) _Pragma("unroll") for (int k = 0; k < 2; ++k) dst[n][k] = *(const PG8_LAS bf16x8*)(lds + PG8_SB(b, h) + boff + n * 2048 + k * 1024); } while (0)
#define PG8_MMA(ai, bj, At, Bt) do { __builtin_amdgcn_s_setprio(1); _Pragma("unroll") for (int m = 0; m < 4; ++m) _Pragma("unroll") for (int n = 0; n < 2; ++n) _Pragma("unroll") for (int k = 0; k < 2; ++k) \
        acc[ai][bj][m][n] = __builtin_amdgcn_mfma_f32_16x16x32_bf16(Bt[n][k], At[m][k], acc[ai][bj][m][n], 0, 0, 0); __builtin_amdgcn_s_setprio(0); } while (0)
#define PG8_WAIT_V(n) asm volatile("s_waitcnt vmcnt(" #n ")" ::: "memory")
#define PG8_WAIT_VI(n) asm volatile("s_waitcnt vmcnt(%0)" :: "i"(n) : "memory")
#define PG8_WAIT_L(n) asm volatile("s_waitcnt lgkmcnt(" #n ")" ::: "memory")
#define PG8_BAR __builtin_amdgcn_s_barrier()
#define PG8_SCHED __builtin_amdgcn_sched_barrier(0)
    Unit cur, nxt; int ui = 0;
    if (!S.next(0, cur)) return;
    f32x4 acc[2][2][4][2];
#pragma unroll
    for (int a = 0; a < 2; ++a)
#pragma unroll
        for (int b = 0; b < 2; ++b)
#pragma unroll
            for (int m = 0; m < 4; ++m)
#pragma unroll
                for (int n = 0; n < 2; ++n) acc[a][b][m][n] = (f32x4){0.f, 0.f, 0.f, 0.f};
    bf16x8 At[4][2], B0[2][2], B1[2][2];
    const char* cA = (const char*)g.A + (size_t)cur.pm * tstep; const char* cB = (const char*)g.Bt + (size_t)cur.pn * tstep;
    S.a_ready(cur);
    if constexpr (SP2) {
        PG8_STAGE(PG8_SB(0, 0), cB, voffB); PG8_STAGE(PG8_SB(0, 1), cB + hstep, voffB); PG8_STAGE(PG8_SA(0, 0), cA, voffA); PG8_STAGE(PG8_SA(0, 1), cA + hstep, voffA);
        if (wr == 1) PG8_BAR;
        PG8_WAIT_V(2); PG8_BAR;
        PG8_STAGE(PG8_SB(1, 0), cB + kstep, voffB); PG8_STAGE(PG8_SA(1, 0), cA + kstep, voffA); PG8_STAGE(PG8_SB(1, 1), cB + hstep + kstep, voffB);
        PG8_WAIT_V(6); PG8_BAR;
    } else {
        PG8_STAGE(PG8_SB(0, 0), cB, voffB); PG8_STAGE(PG8_SA(0, 0), cA, voffA); PG8_STAGE(PG8_SB(0, 1), cB + hstep, voffB); PG8_STAGE(PG8_SA(0, 1), cA + hstep, voffA);
        if (wr == 1) PG8_BAR;
        PG8_WAIT_V(4); PG8_BAR;
        PG8_STAGE(PG8_SB(1, 0), cB + kstep, voffB); PG8_STAGE(PG8_SA(1, 0), cA + kstep, voffA); PG8_STAGE(PG8_SB(1, 1), cB + hstep + kstep, voffB);
        PG8_WAIT_V(6); PG8_BAR;
    }
    for (;;) {
        const bool has_next = S.next(DUAL ? ((ui + 1) >> 1) : (ui + 1), nxt);
        const bf16_t* nAm = (DUAL && ((ui + 1) & 1)) ? g.A2 : g.A; const bf16_t* nBm = (DUAL && ((ui + 1) & 1)) ? g.Bt2 : g.Bt;
        const char* nA = has_next ? (const char*)nAm + (size_t)nxt.pm * tstep : cA; const char* nB = has_next ? (const char*)nBm + (size_t)nxt.pn * tstep : cB;
        for (int t = 0; t < nt; t += 2) {
            const bool last = (t == nt - 2);
            const char* a1 = cA + (size_t)(t + 1) * kstep;
            const char* a2 = last ? nA : cA + (size_t)(t + 2) * kstep; const char* b2 = last ? nB : cB + (size_t)(t + 2) * kstep;
            const char* a3 = a2 + kstep; const char* b3 = b2 + kstep;
            if (last && has_next) S.a_ready(nxt);
            if constexpr (SP2) {
            int rl = __builtin_amdgcn_readfirstlane((Epi::SEAM_VMOPS > 0 && t == 0 && ui > 0) ? 1 : 0); if (Epi::SEAM_VMOPS > 0) asm volatile("" : "+s"(rl));
            PG8_LDB(B0, 0, 0); PG8_LDB(B1, 0, 1); PG8_SCHED; PG8_LDA(At, 0, 0); PG8_STAGE(PG8_SA(1, 1), a1 + hstep, voffA);
            if (Epi::SEAM_VMOPS > 0 && rl) PG8_WAIT_VI(8 + Epi::SEAM_VMOPS); else PG8_WAIT_V(8);
            PG8_WAIT_L(0); PG8_BAR; PG8_MMA(0, 0, At, B0); PG8_MMA(0, 1, At, B1); PG8_BAR; PG8_SCHED;
            PG8_LDA(At, 0, 1); PG8_STAGE(PG8_SB(0, 0), b2, voffB); PG8_STAGE(PG8_SB(0, 1), b2 + hstep, voffB); PG8_STAGE(PG8_SA(0, 0), a2, voffA);
            if (Epi::SEAM_VMOPS > 0 && rl) PG8_WAIT_VI(8 + Epi::SEAM_VMOPS); else PG8_WAIT_V(8);
            PG8_WAIT_L(0); PG8_BAR; PG8_MMA(1, 0, At, B0); PG8_MMA(1, 1, At, B1); PG8_BAR; PG8_SCHED;
            PG8_LDB(B0, 1, 0); PG8_LDB(B1, 1, 1); PG8_SCHED; PG8_LDA(At, 1, 0); PG8_STAGE(PG8_SA(0, 1), a2 + hstep, voffA);
            PG8_WAIT_V(8); PG8_WAIT_L(0); PG8_BAR; PG8_MMA(0, 0, At, B0); PG8_MMA(0, 1, At, B1); PG8_BAR; PG8_SCHED;
            PG8_LDA(At, 1, 1); PG8_STAGE(PG8_SB(1, 0), b3, voffB); PG8_STAGE(PG8_SB(1, 1), b3 + hstep, voffB); PG8_STAGE(PG8_SA(1, 0), a3, voffA);
            PG8_WAIT_V(8); PG8_WAIT_L(0); PG8_BAR; PG8_MMA(1, 0, At, B0); PG8_MMA(1, 1, At, B1); PG8_BAR; PG8_SCHED;
            } else {
            PG8_LDB(B0, 0, 0); PG8_SCHED; PG8_LDA(At, 0, 0); PG8_STAGE(PG8_SA(1, 1), a1 + hstep, voffA);
            PG8_WAIT_L(8); PG8_BAR; PG8_WAIT_L(0); PG8_MMA(0, 0, At, B0); PG8_BAR; PG8_SCHED;
            PG8_LDB(B1, 0, 1); PG8_STAGE(PG8_SB(0, 0), b2, voffB);
            PG8_BAR; PG8_WAIT_L(0); PG8_MMA(0, 1, At, B1); PG8_BAR;
            PG8_LDA(At, 0, 1); PG8_STAGE(PG8_SA(0, 0), a2, voffA);
            PG8_BAR; PG8_WAIT_L(0); PG8_MMA(1, 0, At, B0); PG8_BAR; PG8_SCHED;
            PG8_STAGE(PG8_SB(0, 1), b2 + hstep, voffB);
            PG8_WAIT_V(6); PG8_BAR; PG8_MMA(1, 1, At, B1); PG8_BAR;
            PG8_LDB(B0, 1, 0); PG8_SCHED; PG8_LDA(At, 1, 0); PG8_STAGE(PG8_SA(0, 1), a2 + hstep, voffA);
            PG8_WAIT_L(8); PG8_BAR; PG8_WAIT_L(0); PG8_MMA(0, 0, At, B0); PG8_BAR; PG8_SCHED;
            PG8_LDB(B1, 1, 1); PG8_STAGE(PG8_SB(1, 0), b3, voffB);
            PG8_BAR; PG8_WAIT_L(0); PG8_MMA(0, 1, At, B1); PG8_BAR;
            PG8_LDA(At, 1, 1); PG8_STAGE(PG8_SA(1, 0), a3, voffA);
            PG8_BAR; PG8_WAIT_L(0); PG8_MMA(1, 0, At, B0); PG8_BAR; PG8_SCHED;
            PG8_STAGE(PG8_SB(1, 1), b3 + hstep, voffB);
            PG8_WAIT_V(6); PG8_BAR; PG8_MMA(1, 1, At, B1); PG8_BAR;
            }
        }
        if constexpr (ALIGN_EPI) { if (wr == 0) PG8_BAR; }
        const bool keep = DUAL && !(ui & 1);
        if constexpr (DUAL) { if (keep) E.mid(acc, cur, wr, wc, fr, fq); else { E(acc, cur, wr, wc, fr, fq); S.done(cur); } }
        else if constexpr (!Epi::AFTER_DRAIN) { E(acc, cur, wr, wc, fr, fq); S.done(cur); }
        if (!has_next) break;
        if (!keep) {
#pragma unroll
        for (int a = 0; a < 2; ++a)
#pragma unroll
            for (int b = 0; b < 2; ++b)
#pragma unroll
                for (int m = 0; m < 4; ++m)
#pragma unroll
                    for (int n = 0; n < 2; ++n) acc[a][b][m][n] = (f32x4){0.f, 0.f, 0.f, 0.f};
        }
        cur = nxt; cA = nA; cB = nB; ++ui;
        if constexpr (ALIGN_EPI) { if (wr == 1) PG8_BAR; }
    }
    PG8_WAIT_V(0);
    if constexpr (!ALIGN_EPI) { if (wr == 0) PG8_BAR; }
    PG8_BAR;
    if constexpr (Epi::AFTER_DRAIN) { E.fused(acc, cur, wr, wc, fr, fq, lds, wid, lane); S.done(cur); }
#undef PG8_SA
#undef PG8_SB
#undef PG8_STAGE
#undef PG8_LDA
#undef PG8_LDB
#undef PG8_MMA
#undef PG8_WAIT_V
#undef PG8_WAIT_VI
#undef PG8_WAIT_L
#undef PG8_BAR
#undef PG8_SCHED
}
}
#ifndef PG8_SP2
#define PG8_SP2 true
#endif
#ifndef PG8_ALIGN
#define PG8_ALIGN true
#endif
constexpr int NWAVES = 8;
#ifndef MK_N_LAUNCHES
#define MK_N_LAUNCHES 1
#endif
constexpr int N_PHASES = 10;
constexpr int N_LAUNCHES = MK_N_LAUNCHES;

constexpr int BATCH = 8, SEQ = 2048, DM = 2048, M = BATCH * SEQ;
constexpr int NH = 8, HD = 128, AW = 1024, MBLK = 256, NBLK = SEQ / MBLK;
constexpr int DFF = 5632, PLED = 256, INW = 11264;
constexpr float NORM_EPS = 1e-6f;

constexpr size_t MiB = 1u << 20;
constexpr size_t WS_CTL = 0, CTL_ZERO_BYTES = 32768;
constexpr size_t WS_RSTD0 = 1 * MiB, WS_LB = WS_RSTD0 + 65536, WS_TB = WS_LB + 4096, WS_KMEAN = WS_RSTD0 + 131072;
constexpr size_t WS_SS1 = 2 * MiB, WS_SS3 = 4 * MiB;
constexpr size_t WS_WIN = 8 * MiB, WS_WGU = 52 * MiB, WS_WDN = 96 * MiB, WS_WOUT = 118 * MiB, WS_WPG = 126 * MiB, WS_WA = 134 * MiB, WS_WB = 138 * MiB, WS_WPLE = 142 * MiB;
constexpr size_t WS_PB = 143 * MiB;
constexpr size_t WS_RA = 152 * MiB;
constexpr size_t WS_ARENA = 216 * MiB, ARENA_STRIDE = 36 * MiB;
constexpr size_t AO_Q = 0, AO_K = 4 * MiB, AO_V = 8 * MiB, AO_QB = 12 * MiB, AO_F = 16 * MiB, AO_IB = 24 * MiB, AO_SG = 28 * MiB, AO_YB = 32 * MiB;
constexpr size_t AO_YA = AO_Q, AO_MIX = AO_K, AO_ACT = AO_QB, AO_PLE = AO_QB, AO_X3B = AO_PLE + 8 * MiB, WS_END = WS_ARENA + 8 * ARENA_STRIDE;
static_assert(AO_ACT + (size_t)SEQ * DFF * 2 <= ARENA_STRIDE && AO_MIX + (size_t)SEQ * DM * 2 <= AO_QB && AO_X3B + (size_t)SEQ * DM * 2 <= ARENA_STRIDE && WS_RA + (size_t)M * DM * 2 <= WS_ARENA && WS_END <= 504 * MiB, "d_ws map");
constexpr int CW_GRP = 512, CW_GRPX = 1536, CW_LATE = 2560, CW_PNL = 3072;
constexpr int CW_BAR = 4096;

constexpr int RING_OFF = 0, RING_BYTES = 131072;
constexpr int LDSCTL_OFF = RING_BYTES, MISC_OFF = LDSCTL_OFF + 320, TAB_OFF = LDSCTL_OFF + 1024;
constexpr int LDS_BYTES = 147456;
static_assert(TAB_OFF + 1024 <= LDS_BYTES, "LDS map");
#define GAS __attribute__((address_space(1)))
#define LAS __attribute__((address_space(3)))
typedef unsigned short bf16;
typedef unsigned v4u __attribute__((ext_vector_type(4)));
typedef float f32x4 __attribute__((ext_vector_type(4)));
typedef short bf16x8 __attribute__((ext_vector_type(8)));
typedef GAS unsigned gu32;
typedef GAS unsigned long long gu64;
#define RLX_AGENT __ATOMIC_RELAXED, __HIP_MEMORY_SCOPE_AGENT
#define LDS_WAIT() asm volatile("s_waitcnt lgkmcnt(0)" ::: "memory")
#define VM_WAIT() asm volatile("s_waitcnt vmcnt(0)" ::: "memory")
__device__ __forceinline__ unsigned long long rt() { return __builtin_amdgcn_s_memrealtime(); }
__device__ __forceinline__ unsigned f2bf(float f) { unsigned u = __builtin_bit_cast(unsigned, f); return (u + 0x7fffu + ((u >> 16) & 1u)) >> 16; }
__device__ __forceinline__ unsigned pk2(float lo, float hi) { unsigned r; asm volatile("v_cvt_pk_bf16_f32 %0, %1, %2" : "=v"(r) : "v"(lo), "v"(hi)); return r; }

#define XB_TMO      128
#define XB_XCNT(j)  (256  + 64 * (j))
#define XB_XSUB(j)  (1280 + 64 * (j))
#define XB_XGEN(j)  (2304 + 64 * (j))
#define XB_TOP      3328
#define XB_TOPGEN   3392
#define XCD_BAR_WORDS 3456
#define XB_SPIN_CAP (1u << 18)

__device__ __forceinline__ unsigned xb_ld(unsigned* p)              { return __hip_atomic_load(p, __ATOMIC_RELAXED, __HIP_MEMORY_SCOPE_AGENT); }
__device__ __forceinline__ unsigned xb_add(unsigned* p, unsigned v) { return __hip_atomic_fetch_add(p, v, __ATOMIC_RELAXED, __HIP_MEMORY_SCOPE_AGENT); }
__device__ __forceinline__ unsigned xb_xcc_id() { return (unsigned)__builtin_amdgcn_s_getreg((3 << 11) | 20) & 0xFu; }
#define XB_SPIN(cond, bar) do { unsigned _sp = 0; while (cond) { __builtin_amdgcn_s_sleep(1); \
    if ((++_sp & 255u) == 0u) { if (xb_ld(&(bar)[XB_TMO])) break; if (_sp > XB_SPIN_CAP) { atomicAdd(&(bar)[XB_TMO], 1u); break; } } } } while (0)

struct XcdBarrier {
    unsigned* bar; unsigned x;
    volatile LAS unsigned* st;
};

__device__ __forceinline__ XcdBarrier xcd_barrier_post(unsigned* bar, volatile LAS unsigned* st) {
    XcdBarrier b; b.bar = bar; b.x = xb_xcc_id(); b.st = st;
    if (threadIdx.x == 0) (void)xb_add(&bar[XB_XCNT(b.x)], 1u);
    return b;
}
__device__ __forceinline__ void xcd_barrier_complete(unsigned* bar, unsigned x, unsigned& nloc, unsigned& nx) {
    const unsigned G = gridDim.x * gridDim.y * gridDim.z;
    unsigned sum, cnt, mine, sp = 0u;
    for (;;) {
        sum = 0u; cnt = 0u; mine = 0u;
#pragma unroll
        for (unsigned j = 0; j < 16; ++j) { const unsigned c = xb_ld(&bar[XB_XCNT(j)]); sum += c; cnt += (c > 0u) ? 1u : 0u; mine = (j == x) ? c : mine; }
        if (sum == G) break;
        __builtin_amdgcn_s_sleep(1);
        if ((++sp & 255u) == 0u) { if (xb_ld(&bar[XB_TMO])) break; if (sp > XB_SPIN_CAP) { atomicAdd(&bar[XB_TMO], 1u); break; } }
    }
    nloc = mine > 0u ? mine : 1u; nx = cnt > 0u ? cnt : 1u;
}

__device__ __forceinline__ void xcd_barrier(const XcdBarrier& b) {
    asm volatile("s_waitcnt vmcnt(0)" ::: "memory");
    __syncthreads();
    if (threadIdx.x == 0) {
        unsigned* bar = b.bar;
        __builtin_amdgcn_s_waitcnt(0);
        unsigned nloc = b.st[0], nx = b.st[1];
        if (nloc == 0u) { xcd_barrier_complete(bar, b.x, nloc, nx); b.st[0] = nloc; b.st[1] = nx; }
        const unsigned old = xb_add(&bar[XB_XSUB(b.x)], 1u);
        const unsigned gen = old / nloc;
        if (old + 1u == (gen + 1u) * nloc) {
            __builtin_amdgcn_fence(__ATOMIC_RELEASE, "agent");
            asm volatile("s_waitcnt vmcnt(0)" ::: "memory");
            const unsigned og = xb_add(&bar[XB_TOP], 1u);
            const unsigned tg = og / nx;
            if (og + 1u == (tg + 1u) * nx) xb_add(&bar[XB_TOPGEN], 1u);
            else XB_SPIN(xb_ld(&bar[XB_TOPGEN]) == tg, bar);
            __builtin_amdgcn_fence(__ATOMIC_ACQUIRE, "agent");
            xb_add(&bar[XB_XGEN(b.x)], 1u);
            asm volatile("s_waitcnt vmcnt(0)" ::: "memory");
        } else {
            XB_SPIN(xb_ld(&bar[XB_XGEN(b.x)]) == gen, bar);
            __builtin_amdgcn_fence(__ATOMIC_ACQUIRE, "agent");
            asm volatile("s_waitcnt vmcnt(0)" ::: "memory");
        }
    }
    __syncthreads();
}

struct GrpBar { unsigned* cnt; unsigned tgt, n; int light; };
__device__ __forceinline__ void grp_barrier(GrpBar& g, unsigned* bar, unsigned* late) {
    asm volatile("s_waitcnt vmcnt(0)" ::: "memory");
    __syncthreads();
    g.tgt += g.n;
    if (threadIdx.x == 0) {
        __builtin_amdgcn_s_waitcnt(0);
        if (!g.light || late) { __builtin_amdgcn_fence(__ATOMIC_RELEASE, "agent"); asm volatile("s_waitcnt vmcnt(0)" ::: "memory"); }
        if (late) (void)xb_add(late, 1u);
        (void)xb_add(g.cnt, 1u);
        XB_SPIN(xb_ld(g.cnt) < g.tgt, bar);
        __builtin_amdgcn_fence(__ATOMIC_ACQUIRE, "agent");
        asm volatile("s_waitcnt vmcnt(0)" ::: "memory");
    }
    __syncthreads();
}
__device__ __forceinline__ void late_wait(unsigned* late, unsigned n, unsigned* bar) {
    if (threadIdx.x == 0) { XB_SPIN(xb_ld(late) < n, bar); __builtin_amdgcn_fence(__ATOMIC_ACQUIRE, "agent"); asm volatile("s_waitcnt vmcnt(0)" ::: "memory"); }
    __syncthreads();
}
__device__ __forceinline__ float wave_sum(float v) {
#pragma unroll
    for (int o = 1; o < 64; o <<= 1) v += __shfl_xor(v, o);
    return v;
}
namespace att {
typedef short s16x4 __attribute__((ext_vector_type(4)));
typedef float f32x16 __attribute__((ext_vector_type(16)));
constexpr int PITCH = 1024, SHM_K = 16384, SHM_V = 16384;
constexpr int L_V = 0, L_K = 2 * SHM_V, L_WS = L_K + 2 * SHM_K, L_KM = L_WS + 8 * 256, L_SEL = L_KM + 4096, L_TB = L_SEL + 1024, L_END = L_TB + 1024;
constexpr float SCALE = 0.08838834764831845f;
#define KSWZ(row, colB) ((row) * 256 + ((colB) ^ (((row) & 7) << 4)))
#define SBAR() __builtin_amdgcn_sched_barrier(0)
__device__ __forceinline__ int v_st(int k, int c) { const int kk = (k & ~0xC) | ((k & 4) << 1) | ((k & 8) >> 1); return ((kk >> 3) * 4 + (c >> 5)) * 512 + ((kk & 7) * 32 + (c & 31)) * 2; }
__device__ __forceinline__ int v_rd_base(int lane) { return ((lane & 3) << 3) | (((lane >> 2) & 3) << 6) | (((lane >> 4) & 1) << 5) | (((lane >> 5) & 1) << 8); }
constexpr int v_rd_off(int d0, int ks, int half) { return d0 * 512 + ks * 4096 + half * 2048; }
__device__ __forceinline__ int crow(int r, int hi) { return (r & 3) + 8 * (r >> 2) + 4 * hi; }
__device__ __forceinline__ unsigned cvtpk(float lo, float hi) { unsigned r; asm volatile("v_cvt_pk_bf16_f32 %0, %1, %2" : "=v"(r) : "v"(lo), "v"(hi)); return r; }

constexpr float THR = 8.f;
__device__ __forceinline__ void partialSM(f32x16& p0, f32x16& p1, float& m_reg, float& mn, float& alpha) {
    float pmax = p0[0];
#pragma unroll
    for (int r = 1; r < 16; ++r) pmax = fmaxf(pmax, p0[r]);
#pragma unroll
    for (int r = 0; r < 16; ++r) pmax = fmaxf(pmax, p1[r]);
    { auto rr = __builtin_amdgcn_permlane32_swap(__float_as_uint(pmax), __float_as_uint(pmax), false, false);
      pmax = fmaxf(__uint_as_float(rr[0]), __uint_as_float(rr[1])); }
    constexpr float C2 = 1.4426950408889634f * SCALE;
    if (__builtin_expect(__all((pmax - m_reg) * SCALE <= THR), 1)) { mn = m_reg; alpha = 1.f; }
    else { mn = fmaxf(m_reg, pmax); alpha = __builtin_amdgcn_exp2f((m_reg - mn) * C2); m_reg = mn; }
    const float mnL = -mn * C2;
#pragma unroll
    for (int r = 0; r < 16; ++r) p0[r] = fmaf(p0[r], C2, mnL);
#pragma unroll
    for (int r = 0; r < 16; ++r) p1[r] = fmaf(p1[r], C2, mnL);
#pragma unroll
    for (int r = 0; r < 16; ++r) p0[r] = __builtin_amdgcn_exp2f(p0[r]);
}
__device__ __forceinline__ void pack_p(const f32x16& p0, const f32x16& p1, bf16x8& pa0, bf16x8& pa1, bf16x8& pa2, bf16x8& pa3) {
#define PK4(P, B_, OUT) do { unsigned a0 = cvtpk(P[B_+0], P[B_+1]), a1 = cvtpk(P[B_+2], P[B_+3]);                          \
        unsigned b0 = cvtpk(P[B_+4], P[B_+5]), b1 = cvtpk(P[B_+6], P[B_+7]);                                             \
        auto r0 = __builtin_amdgcn_permlane32_swap(a0, b0, false, false); auto r1 = __builtin_amdgcn_permlane32_swap(a1, b1, false, false); \
        v4u w = {r0[0], r1[0], r0[1], r1[1]}; OUT = *reinterpret_cast<bf16x8*>(&w); } while (0)
    PK4(p0, 0, pa0); PK4(p0, 8, pa1); PK4(p1, 0, pa2); PK4(p1, 8, pa3);
#undef PK4
}
__device__ __forceinline__ void finishSM(f32x16& p0, f32x16& p1, float alpha, float& l_reg, bf16x8& pa0, bf16x8& pa1, bf16x8& pa2, bf16x8& pa3) {
#pragma unroll
    for (int r = 0; r < 16; ++r) p1[r] = __builtin_amdgcn_exp2f(p1[r]);
    float ps = 0;
#pragma unroll
    for (int r = 0; r < 16; ++r) ps += p0[r];
#pragma unroll
    for (int r = 0; r < 16; ++r) ps += p1[r];
    { auto rr = __builtin_amdgcn_permlane32_swap(__float_as_uint(ps), __float_as_uint(ps), false, false);
      ps = __uint_as_float(rr[0]) + __uint_as_float(rr[1]); }
    l_reg = l_reg * alpha + ps;
    pack_p(p0, p1, pa0, pa1, pa2, pa3);
}
__device__ __forceinline__ void qkt(f32x16& p0, f32x16& p1, const LAS char* Kb, int r32, int hi, const bf16x8* qr) {
    p0 = f32x16{}; p1 = f32x16{};
    const LAS char* kb[4];
#pragma unroll
    for (int dd = 0; dd < 4; ++dd) kb[dd] = Kb + KSWZ(r32, (dd * 16 + hi * 8) * 2);
#pragma unroll
    for (int d0 = 0; d0 < 8; ++d0) { const LAS char* a = kb[d0 & 3] + (d0 >> 2) * 128;
        const bf16x8 b0 = *reinterpret_cast<const LAS bf16x8*>(a);
        const bf16x8 b1 = *reinterpret_cast<const LAS bf16x8*>(a + 32 * 256);
        p0 = __builtin_amdgcn_mfma_f32_32x32x16_bf16(b0, qr[d0], p0, 0, 0, 0);
        p1 = __builtin_amdgcn_mfma_f32_32x32x16_bf16(b1, qr[d0], p1, 0, 0, 0); }
}
__device__ __forceinline__ void pv_tile(f32x16* o, int vb0, bf16x8 pa0, bf16x8 pa1, bf16x8 pa2, bf16x8 pa3) {
#define TRRD(dst, off) asm volatile("ds_read_b64_tr_b16 %0, %1 offset:%2" : "=&v"(dst) : "v"(vb0), "i"(off) : "memory")
#define PV_D0(d0) do { s16x4 l0, l1, l2, l3, h0, h1, h2, h3; constexpr int b_ = v_rd_off(d0, 0, 0); \
        TRRD(l0, b_); TRRD(h0, b_ + 2048); TRRD(l1, b_ + 4096); TRRD(h1, b_ + 6144); TRRD(l2, b_ + 8192); TRRD(h2, b_ + 10240); TRRD(l3, b_ + 12288); TRRD(h3, b_ + 14336); \
        asm volatile("s_waitcnt lgkmcnt(0)" ::: "memory"); SBAR();   \
        o[d0] = __builtin_amdgcn_mfma_f32_32x32x16_bf16(pa0, (bf16x8){l0[0], l0[1], l0[2], l0[3], h0[0], h0[1], h0[2], h0[3]}, o[d0], 0, 0, 0);   \
        o[d0] = __builtin_amdgcn_mfma_f32_32x32x16_bf16(pa1, (bf16x8){l1[0], l1[1], l1[2], l1[3], h1[0], h1[1], h1[2], h1[3]}, o[d0], 0, 0, 0);   \
        o[d0] = __builtin_amdgcn_mfma_f32_32x32x16_bf16(pa2, (bf16x8){l2[0], l2[1], l2[2], l2[3], h2[0], h2[1], h2[2], h2[3]}, o[d0], 0, 0, 0);   \
        o[d0] = __builtin_amdgcn_mfma_f32_32x32x16_bf16(pa3, (bf16x8){l3[0], l3[1], l3[2], l3[3], h3[0], h3[1], h3[2], h3[3]}, o[d0], 0, 0, 0); } while (0)
    PV_D0(0); PV_D0(1); PV_D0(2); PV_D0(3);
#undef PV_D0
#undef TRRD
}
__device__ __forceinline__ void attn_unit(LAS char* lds, int b, int h, int qb, const bf16* Qg, const bf16* Kg, const bf16* Vg, bf16* Og, const float* kmean, const float* tbh) {
    int tid_ = threadIdx.x; asm volatile("" : "+v"(tid_));
    const int tid = tid_, wid = __builtin_amdgcn_readfirstlane(tid >> 6), lane = tid & 63, r32 = lane & 31, hi = lane >> 5;
    LAS char* V_lds = lds + L_V; LAS char* K_lds = lds + L_K;
    LAS float* wsf = (LAS float*)(lds + L_WS) + wid * 64; LAS float* li_l = wsf; LAS float* al_l = wsf + 32;
    LAS float* KM = (LAS float*)(lds + L_KM); LAS int* SEL = (LAS int*)(lds + L_SEL); LAS float* TB = (LAS float*)(lds + L_TB);
    const size_t rowbase = (size_t)b * SEQ;
    __syncthreads();
    bf16x8 qr[8];
    { const bf16* qp = Qg + (rowbase + (size_t)qb * MBLK + wid * 32 + r32) * PITCH + h * HD + hi * 8;
#pragma unroll
      for (int d0 = 0; d0 < 8; ++d0) qr[d0] = *(const bf16x8*)(qp + d0 * 16); }
    const int sr = tid >> 4, sc8 = (tid & 15) * 8, vst0 = v_st(sr, sc8), vst1 = v_st(32 + sr, sc8), kws = KSWZ(sr, sc8 * 2);
    const bf16* Kh = Kg + rowbase * PITCH + h * HD + sc8; const bf16* Vh = Vg + rowbase * PITCH + h * HD + sc8;
    bf16x8 st_k0, st_k1, st_v0, st_v1;
#define ATT_LOAD(kb) do { st_k0 = *(const bf16x8*)(Kh + (size_t)((kb) + sr) * PITCH); st_k1 = *(const bf16x8*)(Kh + (size_t)((kb) + 32 + sr) * PITCH); \
                          st_v0 = *(const bf16x8*)(Vh + (size_t)((kb) + sr) * PITCH); st_v1 = *(const bf16x8*)(Vh + (size_t)((kb) + 32 + sr) * PITCH); } while (0)
#define ATT_WRITE(bf) do { *(LAS bf16x8*)(K_lds + (bf) * SHM_K + kws) = st_k0; *(LAS bf16x8*)(K_lds + (bf) * SHM_K + kws + 32 * 256) = st_k1; \
                           *(LAS bf16x8*)(V_lds + (bf) * SHM_V + vst0) = st_v0; *(LAS bf16x8*)(V_lds + (bf) * SHM_V + vst1) = st_v1; } while (0)
    ATT_LOAD(0);
    if (tid < 256) { const float* kp = kmean + (size_t)((b * NH + h) * NBLK + (tid >> 5)) * 256 + (tid & 31) * 4;
        *(LAS f32x4*)(KM + tid * 4) = (*(const f32x4*)kp + *(const f32x4*)(kp + 128)) * (1.0f / MBLK); }
    else if (tid < 256 + 129) TB[tid - 256] = tbh[tid - 256];
    __syncthreads();
    {
        const int row = tid >> 1, part = tid & 1;
        const bf16* qp = Qg + (rowbase + (size_t)qb * MBLK + row) * PITCH + h * HD;
        float a4[4] = {0.f, 0.f, 0.f, 0.f};
        if (qb > 3)
#pragma unroll 4
        for (int c = 0; c < 16; ++c) { const v4u qv = *(const v4u*)(qp + c * 8);
            const float q0 = __uint_as_float(qv.x << 16), q1 = __uint_as_float(qv.x & 0xffff0000u), q2 = __uint_as_float(qv.y << 16), q3 = __uint_as_float(qv.y & 0xffff0000u),
                        q4 = __uint_as_float(qv.z << 16), q5 = __uint_as_float(qv.z & 0xffff0000u), q6 = __uint_as_float(qv.w << 16), q7 = __uint_as_float(qv.w & 0xffff0000u);
#pragma unroll
            for (int nn = 0; nn < 4; ++nn) { const LAS float* km = KM + (2 * nn + part) * HD + c * 8; const f32x4 k0 = *(const LAS f32x4*)km, k1 = *(const LAS f32x4*)(km + 4);
                a4[nn] += (q0 * k0[0] + q1 * k0[1]) + (q2 * k0[2] + q3 * k0[3]) + (q4 * k1[0] + q5 * k1[1]) + (q6 * k1[2] + q7 * k1[3]); } }
        float sc[8];
#pragma unroll
        for (int nn = 0; nn < 4; ++nn) { const float ot = __shfl_xor(a4[nn], 1); sc[2 * nn] = part ? ot : a4[nn]; sc[2 * nn + 1] = part ? a4[nn] : ot; }
        int mask = 0;
        if (qb <= 3) mask = (1 << qb) - 1;
        else {
#pragma unroll
            for (int rd = 0; rd < 3; ++rd) { float best = -__builtin_inff(); int bi = 0;
#pragma unroll
                for (int n = 0; n < 8; ++n) { const bool ok = (n < qb) && !((mask >> n) & 1) && (sc[n] > best); best = ok ? sc[n] : best; bi = ok ? n : bi; }
                mask |= 1 << bi; } }
        if (part == 0) SEL[row] = mask;
    }
    ATT_WRITE(0);
    __syncthreads();
    const int selmask = SEL[wid * 32 + r32];
    if (wid >= 4) __builtin_amdgcn_s_setprio(1);
    const int qlo = qb * MBLK + wid * 32, qpos = qlo + r32;
    const int vbase = (int)(uintptr_t)(V_lds) + v_rd_base(lane);
    float m_reg = -1e30f, l_reg = 0.f; f32x16 o[4] = {};
    const int T = 4 * (qb + 1);
    const float NEG = -__builtin_inff();
    f32x16 pA0, pA1, pB0, pB1; float mnA, mnB, alA, alB; bf16x8 pa0, pa1, pa2, pa3;
#define ATT_ACT(t) ((((t) >> 2) == qb) ? ((t) * 64 <= qlo + 31) : (__any((selmask >> ((t) >> 2)) & 1) != 0))
#define ATT_QKT(P0_, P1_, t, KB) do { if (ATT_ACT(t)) qkt(P0_, P1_, K_lds + (KB) * SHM_K, r32, hi, qr); else { _Pragma("unroll") for (int r = 0; r < 16; ++r) { P0_[r] = NEG; P1_[r] = NEG; } } } while (0)
#define ATT_PV(t, VB) do { if (ATT_ACT(t)) pv_tile(o, vbase + (VB) * SHM_V, pa0, pa1, pa2, pa3); } while (0)
#define ATT_MASK(P0_, P1_, t) do { const int n_ = (t) >> 2, kb_ = (t) * 64; if (ATT_ACT(t)) { const bool rowsel = (n_ == qb) || ((selmask >> n_) & 1);                    \
        if (qlo - kb_ - 63 < 128) { const int dq = qpos - kb_ - 4 * hi;                                                                                          \
            _Pragma("unroll") for (int r = 0; r < 16; ++r) { const int c = (r & 3) + 8 * (r >> 2); const int rel0 = dq - c, rel1 = rel0 - 32;                      \
                const int i0 = rel0 < 0 ? 0 : (rel0 > 128 ? 128 : rel0), i1 = rel1 < 0 ? 0 : (rel1 > 128 ? 128 : rel1);                                         \
                const float v0 = P0_[r] + TB[i0], v1 = P1_[r] + TB[i1];                                                                                           \
                P0_[r] = (rowsel && rel0 >= 0) ? v0 : NEG; P1_[r] = (rowsel && rel1 >= 0) ? v1 : NEG;                                                             \
                if ((r & 3) == 3) asm volatile("" ::: "memory"); }                                                                                                \
        } else { _Pragma("unroll") for (int r = 0; r < 16; ++r) { P0_[r] = rowsel ? P0_[r] : NEG; P1_[r] = rowsel ? P1_[r] : NEG; } } } } while (0)
#define ATT_RESC(a) do { if (__any((a) < 1.f)) { if (hi == 0) al_l[r32] = (a); asm volatile("s_waitcnt lgkmcnt(0)" ::: "memory");                                \
        _Pragma("unroll") for (int d_ = 0; d_ < 4; ++d_) _Pragma("unroll") for (int r = 0; r < 16; ++r) o[d_][r] *= al_l[crow(r, hi)]; } } while (0)
    ATT_LOAD(64);
    SBAR(); ATT_QKT(pA0, pA1, 0, 0);
    ATT_MASK(pA0, pA1, 0); partialSM(pA0, pA1, m_reg, mnA, alA);
    ATT_WRITE(1);
    __syncthreads();
#define ATT_HALF_STEP(PX0, PX1, mnX, alX, PY0, PY1, alY, t, KB, VB, SB) do {                                                          \
        SBAR(); ATT_QKT(PX0, PX1, t, KB);                                                                                              \
        finishSM(PY0, PY1, alY, l_reg, pa0, pa1, pa2, pa3); SBAR();                                                                    \
        ATT_LOAD(((t) + 1) * 64); SBAR();                                                                                             \
        ATT_PV((t) - 1, VB); ATT_MASK(PX0, PX1, t); partialSM(PX0, PX1, m_reg, mnX, alX);                                              \
        __syncthreads();                                                                                                               \
        ATT_WRITE(SB);                                                                                                                 \
        ATT_RESC(alX); __syncthreads(); } while (0)
    for (int t = 1; t + 1 < T; t += 2) {
        ATT_HALF_STEP(pB0, pB1, mnB, alB, pA0, pA1, alA, t, 1, 0, 0);
        ATT_HALF_STEP(pA0, pA1, mnA, alA, pB0, pB1, alB, t + 1, 0, 1, 1);
    }
    SBAR(); ATT_QKT(pB0, pB1, T - 1, 1); SBAR();
    finishSM(pA0, pA1, alA, l_reg, pa0, pa1, pa2, pa3); SBAR();
    ATT_PV(T - 2, 0);
    ATT_MASK(pB0, pB1, T - 1); partialSM(pB0, pB1, m_reg, mnB, alB); ATT_RESC(alB);
    finishSM(pB0, pB1, alB, l_reg, pa0, pa1, pa2, pa3); SBAR(); ATT_PV(T - 1, 1);
#undef ATT_HALF_STEP
#undef ATT_RESC
#undef ATT_MASK
#undef ATT_PV
#undef ATT_QKT
#undef ATT_ACT
#undef ATT_LOAD
#undef ATT_WRITE
    __builtin_amdgcn_s_setprio(0);
    if (hi == 0) li_l[r32] = l_reg; asm volatile("s_waitcnt lgkmcnt(0)" ::: "memory");
    bf16* Ow = Og + (rowbase + (size_t)qb * MBLK + wid * 32) * PITCH + h * HD;
#pragma unroll
    for (int r = 0; r < 16; ++r) { const int orow = crow(r, hi); const float rl = __builtin_amdgcn_rcpf(li_l[orow]);
#pragma unroll
        for (int d0 = 0; d0 < 4; ++d0) { const float v = o[d0][r] * rl; const float vn = __shfl_xor(v, 1);
            if ((r32 & 1) == 0) *(unsigned*)(Ow + (size_t)orow * PITCH + d0 * 32 + r32) = cvtpk(v, vn); } }
}
#undef KSWZ
#undef SBAR
}
namespace hg {
using att::f32x16; using att::s16x4; using att::crow; using att::cvtpk;
constexpr int SET_BYTES = 49152, H_KD = 0, H_QD = 16384, H_IV = 32768, H_OB = 2 * SET_BYTES, OB_BYTES = 16384;
static_assert(H_OB + 2 * OB_BYTES <= RING_BYTES, "HGRN LDS map");
#define HG_KSWZ(row, colB) ((row) * 256 + ((colB) ^ (((row) & 7) << 4)))
typedef unsigned u32x2v __attribute__((ext_vector_type(2)));
typedef float f32x2v __attribute__((ext_vector_type(2)));
#define HG_TRRD(dst, base, off) asm volatile("ds_read_b64_tr_b16 %0, %1 offset:%2" : "=&v"(dst) : "v"(base), "i"(off) : "memory")
#define HG_MFMA(a, b, c) __builtin_amdgcn_mfma_f32_32x32x16_bf16(a, b, c, 0, 0, 0)
#define HG_BF8(l, h) ((bf16x8){l[0], l[1], l[2], l[3], h[0], h[1], h[2], h[3]})
#define HG_IBAR() do { asm volatile("s_waitcnt lgkmcnt(0)" ::: "memory"); __builtin_amdgcn_s_barrier(); asm volatile("" ::: "memory"); } while (0)

template <int TH>
__device__ __forceinline__ void m_half(const LAS char* KD, const LAS char* QD, LAS char* OBt, const f32x16 (&S)[4], bf16x8 B0, bf16x8 B1, bf16x8 B2, bf16x8 B3, int vt, int r32, int hi) {
    const int trow = TH * 32 + r32;
    bf16x8 qr[8];
#pragma unroll
    for (int d0 = 0; d0 < 8; ++d0) qr[d0] = *(const LAS bf16x8*)(QD + HG_KSWZ(trow, (d0 * 16 + hi * 8) * 2));
    f32x16 p0 = {}, p1 = {};
    { const LAS char* kb[4];
#pragma unroll
      for (int dd = 0; dd < 4; ++dd) kb[dd] = KD + HG_KSWZ(r32, (dd * 16 + hi * 8) * 2);
#pragma unroll
      for (int d0 = 0; d0 < 8; ++d0) { const LAS char* a = kb[d0 & 3] + (d0 >> 2) * 128;
          p0 = HG_MFMA(*reinterpret_cast<const LAS bf16x8*>(a), qr[d0], p0);
          if (TH == 1) p1 = HG_MFMA(*reinterpret_cast<const LAS bf16x8*>(a + 32 * 256), qr[d0], p1); } }
#pragma unroll
    for (int r = 0; r < 16; ++r) { const int s0 = crow(r, hi); p0[r] = (s0 <= trow) ? p0[r] : 0.f; if (TH == 1) p1[r] = (s0 + 32 <= trow) ? p1[r] : 0.f; }
    bf16x8 pa0, pa1, pa2, pa3; att::pack_p(p0, p1, pa0, pa1, pa2, pa3);
    f32x16 o = {};
    o = HG_MFMA(pa0, B0, o); o = HG_MFMA(pa1, B1, o);
    if (TH == 1) { o = HG_MFMA(pa2, B2, o); o = HG_MFMA(pa3, B3, o); }
#pragma unroll
    for (int dt = 0; dt < 4; ++dt)
#pragma unroll
        for (int s2 = 0; s2 < 2; ++s2) { const int cb = (dt * 32 + 16 * s2 + 4 * hi) * 2;
            const u32x2v a0 = *(const LAS u32x2v*)(QD + HG_KSWZ(trow, cb)), a1 = *(const LAS u32x2v*)(QD + HG_KSWZ(trow, cb + 16));
            v4u aw = {a0.x, a0.y, a1.x, a1.y}; v4u bw = {cvtpk(S[dt][8 * s2 + 0], S[dt][8 * s2 + 1]), cvtpk(S[dt][8 * s2 + 2], S[dt][8 * s2 + 3]), cvtpk(S[dt][8 * s2 + 4], S[dt][8 * s2 + 5]), cvtpk(S[dt][8 * s2 + 6], S[dt][8 * s2 + 7])};
            o = HG_MFMA(*reinterpret_cast<bf16x8*>(&aw), *reinterpret_cast<bf16x8*>(&bw), o); }
#pragma unroll
    for (int r = 0; r < 16; ++r) { const float v = o[r], vn = __shfl_xor(v, 1);
        if ((r32 & 1) == 0) *(LAS unsigned*)(OBt + (TH * 32 + crow(r, hi)) * 256 + (vt * 32 + r32) * 2) = cvtpk(v, vn); }
}
__device__ __forceinline__ void hgrn_unit(LAS char* lds, LAS float* CLb  , int b, int h, const float* Fg, const bf16* QBg, const bf16* IBg, const bf16* SGg, bf16* YB, const float* gain) {
    int tid_ = threadIdx.x; asm volatile("" : "+v"(tid_));
    const int tid = tid_, wid = __builtin_amdgcn_readfirstlane(tid >> 6), lane = tid & 63, r32 = lane & 31, hi = lane >> 5;
    const size_t rowbase = (size_t)b * SEQ; const int colh = h * HD;
    constexpr int NCH = SEQ / 64;
    __syncthreads();
    if (wid < 4) {
        __builtin_amdgcn_s_setprio(1);
        const int vt = wid;
        f32x16 S[4] = {};
        const int g = lane >> 4, q4 = (lane >> 2) & 3, p4 = lane & 3;
        const int kdT = (8 * hi + q4) * 256 + ((32 * (g & 1) + 8 * p4) ^ (16 * q4));
        const int vrd = att::v_rd_base(lane) + vt * 512;
        __syncthreads();
        for (int n = 0; n < NCH; ++n) {
            const LAS char* setp = lds + (n & 1) * SET_BYTES; const LAS char* KD = setp + H_KD; const LAS char* QD = setp + H_QD;
            LAS char* OBt = lds + H_OB + (n & 1) * OB_BYTES; const LAS float* CL = CLb + (n & 1) * 128;
            const int vb = (int)(uintptr_t)(setp + H_IV) + vrd;
            s16x4 l0, l1, l2, l3, h0, h1, h2, h3;
            HG_TRRD(l0, vb, 0); HG_TRRD(h0, vb, 2048); HG_TRRD(l1, vb, 4096); HG_TRRD(h1, vb, 6144); HG_TRRD(l2, vb, 8192); HG_TRRD(h2, vb, 10240); HG_TRRD(l3, vb, 12288); HG_TRRD(h3, vb, 14336);
            asm volatile("s_waitcnt lgkmcnt(0)" ::: "memory"); __builtin_amdgcn_sched_barrier(0);
            const bf16x8 B0 = HG_BF8(l0, h0), B1 = HG_BF8(l1, h1), B2 = HG_BF8(l2, h2), B3 = HG_BF8(l3, h3);
            m_half<0>(KD, QD, OBt, S, B0, B1, B2, B3, vt, r32, hi);
            m_half<1>(KD, QD, OBt, S, B0, B1, B2, B3, vt, r32, hi);
            const int kb = (int)(uintptr_t)KD + kdT;
#pragma unroll
            for (int dt = 0; dt < 4; ++dt) {
                s16x4 a0, a1, a2, a3, a4, a5, a6, a7;
#define HG_KOFF(ks, hf) ((ks) * 4096 + (hf) * 1024 + (((dt) * 64) ^ ((hf) * 64)))
                HG_TRRD(a0, kb, HG_KOFF(0, 0)); HG_TRRD(a1, kb, HG_KOFF(0, 1)); HG_TRRD(a2, kb, HG_KOFF(1, 0)); HG_TRRD(a3, kb, HG_KOFF(1, 1));
                HG_TRRD(a4, kb, HG_KOFF(2, 0)); HG_TRRD(a5, kb, HG_KOFF(2, 1)); HG_TRRD(a6, kb, HG_KOFF(3, 0)); HG_TRRD(a7, kb, HG_KOFF(3, 1));
#undef HG_KOFF
                asm volatile("s_waitcnt lgkmcnt(0)" ::: "memory"); __builtin_amdgcn_sched_barrier(0);
                S[dt] = HG_MFMA(HG_BF8(a0, a1), B0, S[dt]); S[dt] = HG_MFMA(HG_BF8(a2, a3), B1, S[dt]); S[dt] = HG_MFMA(HG_BF8(a4, a5), B2, S[dt]); S[dt] = HG_MFMA(HG_BF8(a6, a7), B3, S[dt]);
#pragma unroll
                for (int gg = 0; gg < 4; ++gg) { const f32x4 c4 = *(const LAS f32x4*)(CL + dt * 32 + 8 * gg + 4 * hi);
#pragma unroll
                    for (int j = 0; j < 4; ++j) S[dt][4 * gg + j] *= c4[j]; }
            }
            HG_IBAR();
        }
        HG_IBAR();
        __builtin_amdgcn_s_setprio(0);
    } else {
        const int ew = wid - 4, te = tid - 256;
        const int g8 = lane >> 3, cq = lane & 7, dch = 32 * ew + 4 * cq;
        const int isr = te >> 4, isc = (te & 15) * 8;
        const int nrow = te >> 2, npart = te & 3;
        f32x4 fraw[8]; u32x2v qraw[8]; bf16x8 iraw[4]; v4u sgraw[4];
#define HG_LOAD(n) do { _Pragma("unroll") for (int tt = 0; tt < 8; ++tt) { const size_t gi = (rowbase + (n) * 64 + 8 * g8 + tt) * AW + colh + dch; fraw[tt] = __builtin_nontemporal_load((const f32x4*)(Fg + gi)); qraw[tt] = __builtin_nontemporal_load((const u32x2v*)(QBg + gi)); } \
        _Pragma("unroll") for (int k = 0; k < 4; ++k) iraw[k] = __builtin_nontemporal_load((const bf16x8*)(IBg + (rowbase + (n) * 64 + isr + 16 * k) * AW + colh + isc)); } while (0)
#define HG_LOADSG(n) do { _Pragma("unroll") for (int k = 0; k < 4; ++k) sgraw[k] = __builtin_nontemporal_load((const v4u*)(SGg + (rowbase + (n) * 64 + nrow) * AW + colh + 32 * npart + 8 * k)); } while (0)
#define HG_ESTAGE(n) do { LAS char* setp = lds + ((n) & 1) * SET_BYTES; LAS char* KD = setp + H_KD; LAS char* QD = setp + H_QD; LAS char* IV = setp + H_IV;                         \
            float lc[8][4], inc[4], exc[4], cl[4];                                                                                                                                  \
            _Pragma("unroll") for (int k = 0; k < 4; ++k) { float c = 1.f; _Pragma("unroll") for (int tt = 0; tt < 8; ++tt) { c *= fraw[tt][k]; lc[tt][k] = c; } inc[k] = c; }       \
            _Pragma("unroll") for (int off = 8; off < 64; off <<= 1) _Pragma("unroll") for (int k = 0; k < 4; ++k) { const float v = __shfl_up(inc[k], off); inc[k] = (lane >= off) ? inc[k] * v : inc[k]; } \
            _Pragma("unroll") for (int k = 0; k < 4; ++k) { const float e = __shfl_up(inc[k], 8); exc[k] = (g8 == 0) ? 1.f : e; cl[k] = __shfl(inc[k], 56 + cq); }                   \
            _Pragma("unroll") for (int tt = 0; tt < 8; ++tt) { float qd[4], kd[4];                                                                                                  \
                const float qq[4] = {__uint_as_float(qraw[tt].x << 16), __uint_as_float(qraw[tt].x & 0xffff0000u), __uint_as_float(qraw[tt].y << 16), __uint_as_float(qraw[tt].y & 0xffff0000u)}; \
                _Pragma("unroll") for (int k = 0; k < 4; ++k) { const float cp = exc[k] * lc[tt][k]; qd[k] = qq[k] * cp; kd[k] = (1.0f - fraw[tt][k]) * __builtin_amdgcn_rcpf(cp); }   \
                const int t = 8 * g8 + tt, a = HG_KSWZ(t, dch * 2);                                                                                                                 \
                u32x2v wq, wk; wq.x = cvtpk(qd[0], qd[1]); wq.y = cvtpk(qd[2], qd[3]); wk.x = cvtpk(kd[0], kd[1]); wk.y = cvtpk(kd[2], kd[3]);                                       \
                *(LAS u32x2v*)(QD + a) = wq; *(LAS u32x2v*)(KD + a) = wk; }                                                                                                         \
            if (g8 == 0) *(LAS f32x4*)(CLb + ((n) & 1) * 128 + dch) = (f32x4){cl[0], cl[1], cl[2], cl[3]};                                                                          \
            _Pragma("unroll") for (int k = 0; k < 4; ++k) *(LAS bf16x8*)(IV + att::v_st(isr + 16 * k, isc)) = iraw[k]; } while (0)
        HG_LOAD(0); HG_ESTAGE(0); HG_LOAD(1); HG_LOADSG(0);
        __syncthreads();
        for (int n = 0; n <= NCH; ++n) {
            if (n >= 1) { const int m = n - 1; const LAS char* OBt = lds + H_OB + (m & 1) * OB_BYTES + nrow * 256 + npart * 64;
                float ov[32]; float ss = 0.f;
#pragma unroll
                for (int k = 0; k < 4; ++k) { const v4u w = *(const LAS v4u*)(OBt + 16 * k);
                    ov[8 * k + 0] = __uint_as_float(w.x << 16); ov[8 * k + 1] = __uint_as_float(w.x & 0xffff0000u); ov[8 * k + 2] = __uint_as_float(w.y << 16); ov[8 * k + 3] = __uint_as_float(w.y & 0xffff0000u);
                    ov[8 * k + 4] = __uint_as_float(w.z << 16); ov[8 * k + 5] = __uint_as_float(w.z & 0xffff0000u); ov[8 * k + 6] = __uint_as_float(w.w << 16); ov[8 * k + 7] = __uint_as_float(w.w & 0xffff0000u); }
#pragma unroll
                for (int j = 0; j < 32; ++j) ss = fmaf(ov[j], ov[j], ss);
                ss += __shfl_xor(ss, 1); ss += __shfl_xor(ss, 2);
                const float rstd = 1.0f / sqrtf(ss * (1.0f / HD) + NORM_EPS);
                bf16* yp = YB + (rowbase + m * 64 + nrow) * AW + colh + 32 * npart; const float* gp = gain + colh + 32 * npart;
#pragma unroll
                for (int k = 0; k < 4; ++k) { const f32x4 g0 = *(const f32x4*)(gp + 8 * k), g1 = *(const f32x4*)(gp + 8 * k + 4); const v4u sw = sgraw[k];
                    v4u yw;
                    yw.x = cvtpk(ov[8 * k + 0] * rstd * g0[0] * __uint_as_float(sw.x << 16), ov[8 * k + 1] * rstd * g0[1] * __uint_as_float(sw.x & 0xffff0000u));
                    yw.y = cvtpk(ov[8 * k + 2] * rstd * g0[2] * __uint_as_float(sw.y << 16), ov[8 * k + 3] * rstd * g0[3] * __uint_as_float(sw.y & 0xffff0000u));
                    yw.z = cvtpk(ov[8 * k + 4] * rstd * g1[0] * __uint_as_float(sw.z << 16), ov[8 * k + 5] * rstd * g1[1] * __uint_as_float(sw.z & 0xffff0000u));
                    yw.w = cvtpk(ov[8 * k + 6] * rstd * g1[2] * __uint_as_float(sw.w << 16), ov[8 * k + 7] * rstd * g1[3] * __uint_as_float(sw.w & 0xffff0000u));
                    *(v4u*)(yp + 8 * k) = yw; } }
            if (n < NCH) HG_LOADSG(n);
            if (n + 1 < NCH) { HG_ESTAGE(n + 1); if (n + 2 < NCH) HG_LOAD(n + 2); }
            HG_IBAR();
        }
#undef HG_ESTAGE
#undef HG_LOADSG
#undef HG_LOAD
    }
}
#undef HG_IBAR
#undef HG_BF8
#undef HG_MFMA
#undef HG_TRRD
#undef HG_KSWZ
}
#define PH_IDS() int tid_ = threadIdx.x; asm volatile("" : "+v"(tid_)); const int tid = tid_, lane = tid & 63, wave = __builtin_amdgcn_readfirstlane(tid >> 6); (void)lane; (void)wave
struct Frame {
    LAS unsigned char* lds;
    volatile LAS unsigned* MISC;
    gu32* ctl;
    int vcu, G;
    unsigned char* ws;
    const float* in[16];
    float* out;
};
__device__ const unsigned char k_t5b[128] = {0, 1, 2, 3, 4, 5, 6, 7, 8, 9, 10, 11, 12, 13, 14, 15, 16, 16, 16, 17, 17, 18, 18, 18, 19, 19, 19, 20, 20, 20, 20, 21, 21, 21, 21, 22, 22, 22, 22, 22, 23, 23, 23, 23, 23, 23,
    24, 24, 24, 24, 24, 24, 25, 25, 25, 25, 25, 25, 25, 26, 26, 26, 26, 26, 26, 26, 26, 27, 27, 27, 27, 27, 27, 27, 27, 27, 27, 28, 28, 28, 28, 28, 28, 28, 28, 28, 28, 29, 29, 29, 29, 29, 29, 29, 29, 29, 29, 29, 29,
    30, 30, 30, 30, 30, 30, 30, 30, 30, 30, 30, 30, 30, 30, 31, 31, 31, 31, 31, 31, 31, 31, 31, 31, 31, 31, 31, 31, 31};

__device__ __forceinline__ void p0_transpose_item(const float* W, int K, int N, bf16* WT, const float* gain, int mapmode, LAS float* scr, int item, int lane) {
    const int nblk = N / 32, kb = item / nblk, nb = item % nblk, k0 = 64 * kb, n0 = 32 * nb;
    const int kr = lane >> 3, nq = 4 * (lane & 7);
    f32x4 v[8];
#pragma unroll
    for (int i = 0; i < 8; ++i) v[i] = __builtin_nontemporal_load((const GAS f32x4*)(W + (size_t)(k0 + 8 * i + kr) * N + n0 + nq));
    if (gain) {
#pragma unroll
        for (int i = 0; i < 8; ++i) v[i] = v[i] * gain[k0 + 8 * i + kr]; }
#pragma unroll
    for (int i = 0; i < 8; ++i) { LAS float* s = scr + (8 * i + kr) * 33 + nq; s[0] = v[i].x; s[1] = v[i].y; s[2] = v[i].z; s[3] = v[i].w; }
    LDS_WAIT(); asm volatile("" ::: "memory");
    int r0 = n0;
    if (mapmode == 1) { const int j = n0 < DFF ? n0 : n0 - DFF; r0 = 256 * (j >> 7) + (j & 127) + (n0 < DFF ? 0 : 128); }
    const int c = lane & 7;
#pragma unroll
    for (int j = 0; j < 4; ++j) { const int n = (lane >> 3) + 8 * j; const LAS float* s = scr + (8 * c) * 33 + n;
        v4u o; o.x = pk2(s[0 * 33], s[1 * 33]); o.y = pk2(s[2 * 33], s[3 * 33]); o.z = pk2(s[4 * 33], s[5 * 33]); o.w = pk2(s[6 * 33], s[7 * 33]);
        *(GAS v4u*)(WT + (size_t)(r0 + n) * K + k0 + 8 * c) = o; }
    LDS_WAIT(); asm volatile("" ::: "memory");
}
constexpr int I_IN = (DM / 64) * (INW / 32), I_GU = (DM / 64) * (2 * DFF / 32), I_DN = (DFF / 64) * (DM / 32), I_SQ = (DM / 64) * (DM / 32), I_AB = (AW / 64) * (DM / 32), I_PLE = (PLED / 64) * (DM / 32);
constexpr int I_LATE = I_GU + I_DN + 2 * I_SQ + 2 * I_AB + I_PLE;
__device__ __forceinline__ void p0_late_item(Frame& F, LAS float* scr, int r, int lane) {
    bf16* Wgu_t = (bf16*)(F.ws + WS_WGU); bf16* Wdn_t = (bf16*)(F.ws + WS_WDN); bf16* Wout_t = (bf16*)(F.ws + WS_WOUT);
    bf16* Wpg_t = (bf16*)(F.ws + WS_WPG); bf16* Wa_t = (bf16*)(F.ws + WS_WA); bf16* Wb_t = (bf16*)(F.ws + WS_WB); bf16* Wple_t = (bf16*)(F.ws + WS_WPLE);
    if (r < I_GU) { p0_transpose_item(F.in[9], DM, 2 * DFF, Wgu_t, F.in[8], 1, scr, r, lane); return; } r -= I_GU;
    if (r < I_DN) { p0_transpose_item(F.in[10], DFF, DM, Wdn_t, nullptr, 0, scr, r, lane); return; } r -= I_DN;
    if (r < I_SQ) { p0_transpose_item(F.in[7], DM, DM, Wout_t, nullptr, 0, scr, r, lane); return; } r -= I_SQ;
    if (r < I_SQ) { p0_transpose_item(F.in[12], DM, DM, Wpg_t, nullptr, 0, scr, r, lane); return; } r -= I_SQ;
    if (r < I_AB) { p0_transpose_item(F.in[5], AW, DM, Wa_t, nullptr, 0, scr, r, lane); return; } r -= I_AB;
    if (r < I_AB) { p0_transpose_item(F.in[6], AW, DM, Wb_t, nullptr, 0, scr, r, lane); return; } r -= I_AB;
    p0_transpose_item(F.in[11], PLED, DM, Wple_t, nullptr, 0, scr, r, lane);
}
__device__ __forceinline__ void p0_filler(Frame& F, int part) {
    PH_IDS();
    LAS float* scr = (LAS float*)(F.lds + RING_OFF + wave * 16384);
    const int gw = F.vcu * NWAVES + wave, NGW = F.G * NWAVES;
    const int nw = (I_LATE - gw + NGW - 1) / NGW, cut = (nw * (int)(blockIdx.x & 7) + 3) / 7;
    const int j0 = part == 0 ? 0 : cut, j1 = part == 0 ? cut : nw;
#pragma nounroll
    for (int j = j0; j < j1; ++j) p0_late_item(F, scr, gw + j * NGW, lane);
}
__device__ __forceinline__ void p0_prologue(Frame& F) {
    PH_IDS();
    LAS float* scr = (LAS float*)(F.lds + RING_OFF + wave * 16384);
    const int gw = F.vcu * NWAVES + wave, NGW = F.G * NWAVES;
    bf16* Win_t = (bf16*)(F.ws + WS_WIN);
#define P0_TRANSPOSES() do { \
    for (int it = gw; it < I_IN; it += NGW) p0_transpose_item(F.in[3], DM, INW, Win_t, F.in[2], 0, scr, it, lane); \
    } while (0)
    const bool xfirst = (wave & 1) != 0;
    if (!xfirst) P0_TRANSPOSES();
    { bf16* XB = (bf16*)(F.ws + WS_RA); float* rstd0 = (float*)(F.ws + WS_RSTD0); const float* x = F.in[0];
      for (int m = gw; m < M; m += NGW) { const GAS f32x4* xr = (const GAS f32x4*)(x + (size_t)m * DM) + lane; f32x4 v[8]; float s = 0.f;
#pragma unroll
          for (int j = 0; j < 8; ++j) { v[j] = __builtin_nontemporal_load(xr + 64 * j); s += (v[j].x * v[j].x + v[j].y * v[j].y) + (v[j].z * v[j].z + v[j].w * v[j].w); }
          s = wave_sum(s); if (lane == 0) rstd0[m] = 1.0f / sqrtf(s * (1.0f / DM) + NORM_EPS);
          GAS unsigned long long* o8 = (GAS unsigned long long*)(XB + (size_t)m * DM) + lane;
#pragma unroll
          for (int j = 0; j < 8; ++j) o8[64 * j] = (unsigned long long)pk2(v[j].x, v[j].y) | ((unsigned long long)pk2(v[j].z, v[j].w) << 32); } }
    { bf16* PB = (bf16*)(F.ws + WS_PB); const GAS f32x4* p4 = (const GAS f32x4*)F.in[1]; GAS unsigned long long* o8 = (GAS unsigned long long*)PB;
      const int gt = gw * 64 + lane, NGT = NGW * 64;
      for (int i = gt; i < M * PLED / 4; i += NGT) { const f32x4 v = __builtin_nontemporal_load(p4 + i); o8[i] = (unsigned long long)pk2(v.x, v.y) | ((unsigned long long)pk2(v.z, v.w) << 32); } }
    if (xfirst) P0_TRANSPOSES();
#undef P0_TRANSPOSES
    if (blockIdx.x == 0) { float* lb = (float*)(F.ws + WS_LB); const float* lg = F.in[14];
        for (int d = tid; d < AW; d += NWAVES * 64) lb[d] = 1.0f / (1.0f + expf(lg[AW + d] - lg[d])); }
    if (blockIdx.x == 1 || F.G == 1) { float* tb = (float*)(F.ws + WS_TB); const float* rb = F.in[13];
        for (int i = tid; i < NH * 129; i += NWAVES * 64) { const int h = i / 129, rel = i % 129; tb[i] = rel < 128 ? (rb[(int)k_t5b[rel] * NH + h] - rb[31 * NH + h]) * (1.0f / att::SCALE) : 0.f; } }
}
__device__ __forceinline__ void p9_final(Frame& F, const bf16* X3B) {
    PH_IDS();
    const float* ssp = (const float*)(F.ws + WS_SS3); const float* gain = F.in[15];
    f32x4 gv[8];
#pragma unroll
    for (int j = 0; j < 8; ++j) gv[j] = *((const GAS f32x4*)gain + lane + 64 * j);
    const int prow0 = (8 * (int)(blockIdx.x & 7) + (int)((blockIdx.x >> 3) & 7)) * 256 + (int)(blockIdx.x >> 6) * 64;
    for (int m = prow0 + wave; m < prow0 + 64; m += NWAVES) {
        float s = lane < 32 ? ssp[(size_t)m * 32 + lane] : 0.f; s = wave_sum(s);
        const float rstd = 1.0f / sqrtf(s * (1.0f / DM) + NORM_EPS);
        const GAS unsigned long long* xi = (const GAS unsigned long long*)(X3B + (size_t)m * DM) + lane; GAS f32x4* xr = (GAS f32x4*)(F.out + (size_t)m * DM) + lane;
        unsigned long long w[8];
#pragma unroll
        for (int j = 0; j < 8; ++j) w[j] = __builtin_nontemporal_load(xi + 64 * j);
#pragma unroll
        for (int j = 0; j < 8; ++j) { const unsigned lo = (unsigned)w[j], hi = (unsigned)(w[j] >> 32);
            f32x4 v = {__uint_as_float(lo << 16), __uint_as_float(lo & 0xffff0000u), __uint_as_float(hi << 16), __uint_as_float(hi & 0xffff0000u)};
            xr[64 * j] = v * rstd * gv[j]; }
    }
}
__device__ __forceinline__ void build_rstd_tab(Frame& F, const float* ssp, int pm) {
    PH_IDS();
    LAS float* tab = (LAS float*)(F.lds + TAB_OFF);
    const int row = tid >> 1, hf = tid & 1; const GAS f32x4* p = (const GAS f32x4*)(ssp + (size_t)(pm * 256 + row) * 32 + hf * 16);
    const f32x4 a = p[0], b = p[1], c = p[2], d = p[3];
    float s = ((a.x + a.y) + (a.z + a.w)) + ((b.x + b.y) + (b.z + b.w)) + ((c.x + c.y) + (c.z + c.w)) + ((d.x + d.y) + (d.z + d.w));
    const float o = __shfl_xor(s, 1); s = hf ? o + s : s + o;
    if (hf == 0) tab[row] = 1.0f / sqrtf(s * (1.0f / DM) + NORM_EPS);
    __syncthreads();
}

__device__ __forceinline__ void build_rstd0_tab(Frame& F, const float* rstd0, int pm) {
    PH_IDS();
    LAS float* tab = (LAS float*)(F.lds + TAB_OFF);
    if (tid < 256) tab[tid] = rstd0[pm * 256 + tid];
    __syncthreads();
}
struct Args { const float* in[16]; float* out; unsigned char* ws; int ph_lo, ph_hi; };
__global__ void __launch_bounds__(NWAVES * 64, 2) mk_fwd(Args args) {
    extern __shared__ __attribute__((aligned(16))) unsigned char lds[];
    Frame F;
    F.lds = (LAS unsigned char*)lds;
    F.MISC = (volatile LAS unsigned*)(F.lds + MISC_OFF);
    F.G = gridDim.x; { const int bx = blockIdx.x; F.vcu = (F.G % 8 == 0) ? (bx % 8) * (F.G / 8) + bx / 8 : bx; }
    F.ws = args.ws; F.ctl = (gu32*)(args.ws + WS_CTL); F.out = args.out;
#pragma unroll
    for (int i = 0; i < 16; ++i) F.in[i] = args.in[i];
    for (int u = threadIdx.x; u < (LDS_BYTES - LDSCTL_OFF) / 4; u += NWAVES * 64) ((LAS unsigned*)(F.lds + LDSCTL_OFF))[u] = 0u;
    __syncthreads();
    XcdBarrier bar; bar.bar = (unsigned*)(F.ctl + CW_BAR); bar.x = 0; bar.st = nullptr;
    if (N_LAUNCHES == 1) bar = xcd_barrier_post((unsigned*)(F.ctl + CW_BAR), F.MISC + 8);
#define GRID_BAR() do { if (N_LAUNCHES == 1) xcd_barrier(bar); } while (0)
    GrpBar gbar; gbar.cnt = (unsigned*)(F.ctl + CW_GRP + 64 * (blockIdx.x & 7)); gbar.tgt = 0u; gbar.n = gridDim.x / 8; gbar.light = 0;
    if (N_LAUNCHES == 1 && threadIdx.x == 0) (void)__hip_atomic_fetch_or((unsigned*)(F.ctl + CW_GRPX + 64 * (blockIdx.x & 7)), 1u << bar.x, RLX_AGENT);
#define GRP_BAR() do { if (N_LAUNCHES == 1) grp_barrier(gbar, (unsigned*)(F.ctl + CW_BAR), nullptr); } while (0)
    GrpBar pbar; pbar.cnt = (unsigned*)(F.ctl + CW_PNL + 16 * (blockIdx.x & 63)); pbar.tgt = 0u; pbar.n = gridDim.x / 64; pbar.light = 0;
#define PNL_BAR() do { if (N_LAUNCHES == 1) grp_barrier(pbar, (unsigned*)(F.ctl + CW_BAR), nullptr); } while (0)
    const int lo = args.ph_lo, hi = args.ph_hi;
#ifndef PH_MASK
#define PH_MASK 0x3ff
#endif
#define IN(k) (((PH_MASK >> (k)) & 1) && lo <= (k) && (k) < hi)
#ifndef DUP_MASK
#define DUP_MASK 0
#endif
#define REP(k) for (int rep_ = 0; rep_ < 1 + ((DUP_MASK >> (k)) & 1); ++rep_)
    unsigned char* ws = args.ws;
    const int c = (int)blockIdx.x, bq = c & 7;
#define ARENA_PTR(off, rowbytes) (ws + WS_ARENA + (size_t)bq * (ARENA_STRIDE - (size_t)SEQ * (rowbytes)) + (off))
    bf16* XS = (bf16*)(ws + WS_RA); bf16* MIX = (bf16*)ARENA_PTR(AO_MIX, DM * 2); bf16* X3B = (bf16*)ARENA_PTR(AO_X3B, DM * 2);
    bf16* Qb = (bf16*)ARENA_PTR(AO_Q, AW * 2); bf16* Kb = (bf16*)ARENA_PTR(AO_K, AW * 2); bf16* Vb = (bf16*)ARENA_PTR(AO_V, AW * 2); bf16* QBb = (bf16*)ARENA_PTR(AO_QB, AW * 2); float* Fb = (float*)ARENA_PTR(AO_F, AW * 4);
    bf16* IBb = (bf16*)ARENA_PTR(AO_IB, AW * 2); bf16* SGb = (bf16*)ARENA_PTR(AO_SG, AW * 2); bf16* YB = (bf16*)ARENA_PTR(AO_YB, AW * 2); bf16* YA = (bf16*)ARENA_PTR(AO_YA, AW * 2);
    bf16* GA = (bf16*)((unsigned char*)args.out + (size_t)bq * (8 * MiB)); bf16* GB = (bf16*)((unsigned char*)GA + 8 * MiB);
    bf16* ACT = (bf16*)ARENA_PTR(AO_ACT, DFF * 2); bf16* PLEb = (bf16*)ARENA_PTR(AO_PLE, DM * 2); bf16* PB = (bf16*)(ws + WS_PB);
#undef ARENA_PTR

    if (IN(0)) { p0_prologue(F); GRID_BAR();
        if (N_LAUNCHES == 1) { const unsigned xm = xb_ld((unsigned*)(F.ctl + CW_GRPX + 64 * (blockIdx.x & 7))); gbar.light = __builtin_amdgcn_readfirstlane((xm & (xm - 1u)) == 0u ? 1 : 0); pbar.light = gbar.light; }
#if defined(PROBE_P0)
        p0_prologue(F); GRID_BAR();
#endif
    }
    if (IN(1)) REP(1) {
        p0_filler(F, 0); __syncthreads();
        pg8::Gemm g{XS, (const bf16*)(ws + WS_WIN), M, INW, DM}; pg8::StaticOrder S; S.init(M, INW, F.G, c);
        pg8::Unit u0; S.next(0, u0); build_rstd0_tab(F, (const float*)(ws + WS_RSTD0), u0.pm);
        pg8::EpiInProj E{Qb, Kb, Vb, QBb, IBb, SGb, GA, GB, Fb, (const PG8_LAS float*)(F.lds + TAB_OFF), (const float*)(ws + WS_LB), (float*)(ws + WS_KMEAN)};
        pg8::gemm_phase<pg8::EpiInProj, pg8::StaticOrder, PG8_ALIGN, PG8_SP2>(F.lds + RING_OFF, g, S, E);
        __syncthreads(); p0_filler(F, 1);
        if (N_LAUNCHES == 1) grp_barrier(gbar, (unsigned*)(F.ctl + CW_BAR), (unsigned*)(F.ctl + CW_LATE));
#if defined(PROBE_KLOOP)
        { pg8::EpiNull E0;
#if PROBE_KLOOP == 2
          pg8::SameTileOrder S0; S0.n = 11; pg8::gemm_phase<pg8::EpiNull, pg8::SameTileOrder, PG8_ALIGN, PG8_SP2>(F.lds + RING_OFF, g, S0, E0);
#else
          pg8::gemm_phase<pg8::EpiNull, pg8::StaticOrder, PG8_ALIGN, PG8_SP2>(F.lds + RING_OFF, g, S, E0);
#endif
          GRID_BAR(); }
#endif
    }
    {
        const float* kmp = (const float*)(ws + WS_KMEAN); const float* tb = (const float*)(ws + WS_TB);
#define P2_BODY(do_h, do_a) do {                                                                                                                                                  \
        if (F.G == 256) {                                                                                                                                                       \
            const int xg = F.vcu >> 5, xi = F.vcu & 31;                                                                                                                         \
            if (xi < 8) { const int it = xg * 8 + xi; if (do_h) hg::hgrn_unit((LAS char*)(F.lds + RING_OFF), (LAS float*)(F.lds + TAB_OFF), it / NH, it % NH, Fb, QBb, IBb, SGb, YB, F.in[4]); } \
            else { const int a = xg * 24 + (xi - 8), bh = a / 3, grp = a - 3 * bh, b = bh / NH, h = bh % NH;                                                                    \
                const int list = grp == 0 ? 0x37 : (grp == 1 ? 0x126 : 0x045), cnt = grp == 0 ? 2 : 3;       \
                if (do_a) { _Pragma("nounroll") for (int i = 0; i < cnt; ++i) att::attn_unit((LAS char*)(F.lds + RING_OFF), b, h, (list >> (4 * i)) & 15, Qb, Kb, Vb, YA, kmp, tb + h * 129); } } \
        } else {                                                                                                                                                                \
            for (int it = F.vcu; it < BATCH * NH; it += F.G) hg::hgrn_unit((LAS char*)(F.lds + RING_OFF), (LAS float*)(F.lds + TAB_OFF), it / NH, it % NH, Fb, QBb, IBb, SGb, YB, F.in[4]);  \
            for (int v = F.vcu; v < BATCH * NH * NBLK; v += F.G) { const int bh = v >> 3; att::attn_unit((LAS char*)(F.lds + RING_OFF), bh / NH, bh % NH, 7 - (v & 7), Qb, Kb, Vb, YA, kmp, tb + (bh % NH) * 129); } \
        }                                                                                                                                                                       \
        GRP_BAR(); } while (0)
        if (IN(2)) { P2_BODY(true, true);
#if defined(PROBE_P2)
            P2_BODY((PROBE_P2 & 2) != 0, (PROBE_P2 & 1) != 0);
#endif
        }
#undef P2_BODY
    }
#if defined(PROBE_XBAR)
    GRID_BAR();
#endif
    if (IN(4)) REP(4) {
        if (N_LAUNCHES == 1) late_wait((unsigned*)(F.ctl + CW_LATE), gridDim.x, (unsigned*)(F.ctl + CW_BAR));
        pg8::Gemm g{YA, (const bf16*)(ws + WS_WA), M, DM, AW, YB, (const bf16*)(ws + WS_WB)}; pg8::StaticOrder S; S.init(M, DM, F.G, c); pg8::EpiMix2 E{MIX, GA, GB};
        pg8::gemm_phase<pg8::EpiMix2, pg8::StaticOrder, PG8_ALIGN, PG8_SP2, true>(F.lds + RING_OFF, g, S, E);
        GRP_BAR();
    }
    if (IN(5)) REP(5) {
        pg8::Gemm g{MIX, (const bf16*)(ws + WS_WOUT), M, DM, DM}; pg8::StaticOrder S; S.init(M, DM, F.G, c);
        pg8::EpiResid<true> E{XS, XS, (float*)(ws + WS_SS1)};
        pg8::gemm_phase<pg8::EpiResid<true>, pg8::StaticOrder, PG8_ALIGN, PG8_SP2>(F.lds + RING_OFF, g, S, E);
        PNL_BAR();
    }
    if (IN(6)) REP(6) {
        pg8::Gemm g{XS, (const bf16*)(ws + WS_WGU), M, 2 * DFF, DM}; pg8::StaticOrder S; S.init(M, 2 * DFF, F.G, c);
        pg8::Unit u0; S.next(0, u0); build_rstd_tab(F, (const float*)(ws + WS_SS1), u0.pm);
        pg8::EpiGateUp E{ACT, (const PG8_LAS float*)(F.lds + TAB_OFF), DFF};
        pg8::gemm_phase<pg8::EpiGateUp, pg8::StaticOrder, PG8_ALIGN, PG8_SP2>(F.lds + RING_OFF, g, S, E);
        PNL_BAR();
    }
    if (IN(7)) {
        pg8::Gemm g{ACT, (const bf16*)(ws + WS_WDN), M, DM, DFF}; pg8::StaticOrder S; S.init(M, DM, F.G, c);
        pg8::EpiResid<false> E{XS, XS, nullptr};
        pg8::gemm_phase<pg8::EpiResid<false>, pg8::StaticOrder, PG8_ALIGN, PG8_SP2>(F.lds + RING_OFF, g, S, E);
        GRP_BAR();
    }
    if (IN(8)) {
        { pg8::Gemm g{PB, (const bf16*)(ws + WS_WPLE), M, DM, PLED}; pg8::StaticOrder S; S.init(M, DM, F.G, c); pg8::EpiPle E{PLEb};
          pg8::gemm_phase<pg8::EpiPle, pg8::StaticOrder, PG8_ALIGN, PG8_SP2>(F.lds + RING_OFF, g, S, E); }
        VM_WAIT(); __syncthreads();
        { pg8::Gemm g{XS, (const bf16*)(ws + WS_WPG), M, DM, DM}; pg8::StaticOrder S; S.init(M, DM, F.G, c); pg8::EpiPleGate E{XS, X3B, PLEb, (float*)(ws + WS_SS3)};
          pg8::gemm_phase<pg8::EpiPleGate, pg8::StaticOrder, PG8_ALIGN, PG8_SP2>(F.lds + RING_OFF, g, S, E); }
        PNL_BAR();
    }
    if (IN(9)) { p9_final(F, X3B); }
#undef IN
#undef GRID_BAR
#undef GRP_BAR
#undef PNL_BAR
}

extern "C" void kernel_launch(void* const* d_in, const int* in_sizes, int n_in, void* d_out, int out_size, void* d_ws, size_t ws_size, hipStream_t stream) {
    static int grid = 0;
    if (grid == 0) {
        if (n_in != 16 || in_sizes[0] != M * DM || out_size != M * DM || ws_size < WS_END) { fprintf(stderr, "kernel_launch: shape/workspace mismatch (n_in %d, in0 %d, out %d, ws %zu, need %zu); nothing launched\n", n_in, n_in > 0 ? in_sizes[0] : -1, out_size, ws_size, (size_t)WS_END); grid = -1; return; }
        int dev = 0, cus = 0, per_cu = 0;
        if (hipGetDevice(&dev) != hipSuccess || hipDeviceGetAttribute(&cus, hipDeviceAttributeMultiprocessorCount, dev) != hipSuccess) { fprintf(stderr, "kernel_launch: device query failed\n"); grid = -1; return; }
        if (hipFuncSetAttribute((const void*)mk_fwd, hipFuncAttributeMaxDynamicSharedMemorySize, LDS_BYTES) != hipSuccess) { fprintf(stderr, "kernel_launch: hipFuncSetAttribute failed\n"); grid = -1; return; }
        if (hipOccupancyMaxActiveBlocksPerMultiprocessor(&per_cu, (const void*)mk_fwd, NWAVES * 64, LDS_BYTES) != hipSuccess || per_cu < 1) { fprintf(stderr, "kernel_launch: occupancy query reports %d workgroups per CU\n", per_cu); }
        (void)hipGetLastError();
        if (cus != 256) { fprintf(stderr, "kernel_launch: %d CUs; this kernel's batch-group layout needs 256\n", cus); grid = -1; return; }
        grid = cus;
    }
    if (grid < 0) return;
    if (hipMemsetAsync((char*)d_ws + WS_CTL, 0, CTL_ZERO_BYTES, stream) != hipSuccess) { fprintf(stderr, "kernel_launch: memset failed\n"); return; }
    Args a{};
    for (int i = 0; i < 16; ++i) a.in[i] = (const float*)d_in[i];
    a.out = (float*)d_out; a.ws = (unsigned char*)d_ws;
    for (int li = 0; li < N_LAUNCHES; ++li) {
        a.ph_lo = (N_LAUNCHES == 1) ? 0 : li; a.ph_hi = (N_LAUNCHES == 1) ? N_PHASES : li + 1;
        hipLaunchKernelGGL(mk_fwd, dim3(grid), dim3(NWAVES * 64), LDS_BYTES, stream, a);
        const hipError_t le = hipPeekAtLastError();
        if (le != hipSuccess) { fprintf(stderr, "kernel_launch: launch %d failed: %s\n", li, hipGetErrorName(le)); break; }
    }
}
```

```cpp
#include <hip/hip_runtime.h>
#include <cstdio>
#include <cstdint>
namespace pg8 {
#define PG8_LAS __attribute__((address_space(3)))
typedef unsigned short bf16_t;
typedef short bf16x8 __attribute__((ext_vector_type(8)));
typedef float f32x4 __attribute__((ext_vector_type(4)));
typedef unsigned u32x4 __attribute__((ext_vector_type(4)));
constexpr int BM = 256, BK = 64, HALF = 128, HTB = HALF * BK * 2  , STAGE_BYTES = 8 * HTB, NXCD = 8, WGM = 8;

__host__ __device__ __forceinline__ int lds_byte(int r, int c) { const int st = (r >> 4) * 2 + (c >> 5), rr = r & 15, cc = c & 31, ob = rr * 64 + cc * 2; return st * 1024 + (ob ^ (((ob >> 9) & 1) << 5)); }
__host__ __device__ __forceinline__ void stage_rc(int b, int& R, int& C) { const int st = b / 1024, sb = b % 1024, swz = sb ^ (((sb >> 9) & 1) << 5); R = (st >> 1) * 16 + swz / 64; C = (st & 1) * 32 + (swz % 64) / 2; }
__host__ __device__ __forceinline__ int perm32(int rho) { const int n = rho >> 4, i = rho & 15; return 8 * (i >> 2) + 4 * n + (i & 3); }

struct Unit { int pm, pn; };
struct Gemm { const bf16_t* A; const bf16_t* Bt; int M, N, K; const bf16_t* A2; const bf16_t* Bt2; };

struct StaticOrder {
    int nM, nN, nwg, G, c;
    __host__ __device__ __forceinline__ void init(int M, int N, int G_, int c_) { nM = M / BM; nN = N / BM; nwg = nM * nN; G = G_; c = c_; }
    __host__ __device__ __forceinline__ bool next(int i, Unit& u) const {
        const long L = (long)i * G + c; if (L >= nwg) return false;
        int wgid = (int)L; { const int q = nwg / NXCD, r = nwg % NXCD, xcd = wgid % NXCD, off = wgid / NXCD; wgid = (xcd < r ? xcd * (q + 1) : r * (q + 1) + (xcd - r) * q) + off; }
        const int nig = WGM * nN, gid = wgid / nig, fm = gid * WGM, gsz = (nM - fm) < WGM ? (nM - fm) : WGM;
        u.pm = fm + ((wgid % nig) % gsz); u.pn = (wgid % nig) / gsz; return true;
    }
    __device__ __forceinline__ void a_ready(const Unit&) const {}
    __device__ __forceinline__ void done(const Unit&) const {}
};
__device__ __forceinline__ unsigned cvt_pk_bf16(float lo, float hi) { unsigned r; asm volatile("v_cvt_pk_bf16_f32 %0, %1, %2" : "=v"(r) : "v"(lo), "v"(hi)); return r; }
typedef float f32x2 __attribute__((ext_vector_type(2)));
__device__ __forceinline__ float sigm(float v) { return __builtin_amdgcn_rcpf(1.0f + __expf(-v)); }
__device__ __forceinline__ float bf_lo(unsigned w) { return __uint_as_float(w << 16); }
__device__ __forceinline__ float bf_hi(unsigned w) { return __uint_as_float(w & 0xffff0000u); }
__device__ __forceinline__ u32x4 pack8(f32x4 v0, f32x4 v1) { u32x4 w; w.x = cvt_pk_bf16(v0[0], v0[1]); w.y = cvt_pk_bf16(v0[2], v0[3]); w.z = cvt_pk_bf16(v1[0], v1[1]); w.w = cvt_pk_bf16(v1[2], v1[3]); return w; }
typedef unsigned u32x2 __attribute__((ext_vector_type(2)));
__device__ __forceinline__ f32x4 sig4(f32x4 a, float rneg) { f32x4 t = a * rneg, e; e[0] = __builtin_amdgcn_exp2f(t[0]); e[1] = __builtin_amdgcn_exp2f(t[1]); e[2] = __builtin_amdgcn_exp2f(t[2]); e[3] = __builtin_amdgcn_exp2f(t[3]);
    e = e + 1.0f; f32x4 o; o[0] = __builtin_amdgcn_rcpf(e[0]); o[1] = __builtin_amdgcn_rcpf(e[1]); o[2] = __builtin_amdgcn_rcpf(e[2]); o[3] = __builtin_amdgcn_rcpf(e[3]); return o; }

struct EpiInProj {
    static constexpr bool PERM = true, AFTER_DRAIN = false; static constexpr int SEAM_VMOPS = 16;
    bf16_t *Q, *K, *V, *QB, *IB, *SG, *GA, *GB; float* F; const PG8_LAS float* tab; const float* lb; float* KMP;
    __device__ __forceinline__ void operator()(const f32x4 (&acc)[2][2][4][2], const Unit& u, int wr, int wc, int fr, int fq) const {
        const int seg = u.pn >> 2; const int rl0 = wr * 64 + fr, row0 = u.pm * BM + rl0;
        int mode = 0, ldc = 1024, colt = (u.pn & 3) * 256; bf16_t* ob = Q;
        if (seg == 1) ob = K; else if (seg == 2) ob = V; else if (seg == 3) ob = QB; else if (seg == 4) mode = 1; else if (seg == 5) ob = IB; else if (seg == 6) { ob = SG; mode = 2; }
        else if (seg == 7 || seg == 8) { ob = GA; mode = 3; ldc = 2048; colt = (u.pn - 28) * 256; } else if (seg >= 9) { ob = GB; mode = 3; ldc = 2048; colt = (u.pn - 36) * 256; }
        const int col0 = colt + wc * 32 + 8 * fq;
        if (mode == 1) {
            f32x4 lbv[2][2];
#pragma unroll
            for (int bj = 0; bj < 2; ++bj)
#pragma unroll
                for (int n = 0; n < 2; ++n) lbv[bj][n] = *(const f32x4*)(lb + col0 + bj * HALF + 4 * n);
#pragma unroll
            for (int ai = 0; ai < 2; ++ai)
#pragma unroll
                for (int m = 0; m < 4; ++m) { const int row = row0 + ai * HALF + m * 16; const float r = tab[rl0 + ai * HALF + m * 16]; float* rowp = F + (size_t)row * 1024 + col0;
#pragma unroll
                    for (int bj = 0; bj < 2; ++bj)
#pragma unroll
                        for (int n = 0; n < 2; ++n) { const f32x4 l = lbv[bj][n]; const f32x4 o = l + (1.0f - l) * sig4(acc[ai][bj][m][n], r * -1.4426950408889634f);
                            *(f32x4*)(rowp + bj * HALF + 4 * n) = o; } }
        } else {
            if (seg == 1) {
                f32x4 cs[2][2];
#pragma unroll
                for (int bj = 0; bj < 2; ++bj)
#pragma unroll
                    for (int n = 0; n < 2; ++n) { f32x4 s = {0.f, 0.f, 0.f, 0.f};
#pragma unroll
                        for (int ai = 0; ai < 2; ++ai)
#pragma unroll
                            for (int m = 0; m < 4; ++m) s += acc[ai][bj][m][n] * tab[rl0 + ai * HALF + m * 16];
#pragma unroll
                        for (int o = 1; o < 16; o <<= 1) { s[0] += __shfl_xor(s[0], o); s[1] += __shfl_xor(s[1], o); s[2] += __shfl_xor(s[2], o); s[3] += __shfl_xor(s[3], o); }
                        cs[bj][n] = s; }
                if (fr == 0) {
#pragma unroll
                    for (int bj = 0; bj < 2; ++bj)
#pragma unroll
                        for (int n = 0; n < 2; ++n) *(f32x4*)(KMP + ((size_t)(((u.pm >> 3) * 8 + (2 * (u.pn & 3) + bj)) * 8 + (u.pm & 7)) * 2 + wr) * 128 + wc * 32 + 8 * fq + 4 * n) = cs[bj][n]; }
            }
#pragma unroll
            for (int ai = 0; ai < 2; ++ai)
#pragma unroll
                for (int m = 0; m < 4; ++m) { const int row = row0 + ai * HALF + m * 16; const float r = tab[rl0 + ai * HALF + m * 16]; bf16_t* rowp = ob + (size_t)row * ldc + col0;
#pragma unroll
                    for (int bj = 0; bj < 2; ++bj) { f32x4 v0, v1; const float rneg = r * -1.4426950408889634f;
                        if (mode == 3) { v0 = sig4(acc[ai][bj][m][0], rneg); v1 = sig4(acc[ai][bj][m][1], rneg); }
                        else { v0 = acc[ai][bj][m][0] * r; v1 = acc[ai][bj][m][1] * r; if (mode == 2) { v0 = v0 * sig4(acc[ai][bj][m][0], rneg); v1 = v1 * sig4(acc[ai][bj][m][1], rneg); } }
                        *(u32x4*)(rowp + bj * HALF) = pack8(v0, v1); } }
        }
    }
};
struct EpiMix2 {
    static constexpr bool PERM = true, AFTER_DRAIN = false; static constexpr int SEAM_VMOPS = 16;
    bf16_t* MIX; const bf16_t* GA; const bf16_t* GB;
    __device__ __forceinline__ void mid(f32x4 (&acc)[2][2][4][2], const Unit& u, int wr, int wc, int fr, int fq) const {
        const int row0 = u.pm * BM + wr * 64 + fr, col0 = u.pn * BM + wc * 32 + 8 * fq;
        u32x4 ga[2][2][2], gb[2][2][2];
#define MX_LOAD(q) do { _Pragma("unroll") for (int m2 = 0; m2 < 2; ++m2) _Pragma("unroll") for (int bj = 0; bj < 2; ++bj) { const size_t off = (size_t)(row0 + ((q) >> 1) * HALF + (2 * ((q) & 1) + m2) * 16) * 2048 + col0 + bj * HALF; \
            ga[(q) & 1][m2][bj] = *(const u32x4*)(GA + off); gb[(q) & 1][m2][bj] = *(const u32x4*)(GB + off); } } while (0)
#define MX_COMP(q) do { _Pragma("unroll") for (int m2 = 0; m2 < 2; ++m2) _Pragma("unroll") for (int bj = 0; bj < 2; ++bj) { const u32x4 a = ga[(q) & 1][m2][bj], b = gb[(q) & 1][m2][bj]; \
            f32x4& v0 = acc[(q) >> 1][bj][2 * ((q) & 1) + m2][0]; f32x4& v1 = acc[(q) >> 1][bj][2 * ((q) & 1) + m2][1]; \
            v0[0] *= bf_lo(a.x) * __builtin_amdgcn_rcpf(bf_lo(b.x)); v0[1] *= bf_hi(a.x) * __builtin_amdgcn_rcpf(bf_hi(b.x)); v0[2] *= bf_lo(a.y) * __builtin_amdgcn_rcpf(bf_lo(b.y)); v0[3] *= bf_hi(a.y) * __builtin_amdgcn_rcpf(bf_hi(b.y)); \
            v1[0] *= bf_lo(a.z) * __builtin_amdgcn_rcpf(bf_lo(b.z)); v1[1] *= bf_hi(a.z) * __builtin_amdgcn_rcpf(bf_hi(b.z)); v1[2] *= bf_lo(a.w) * __builtin_amdgcn_rcpf(bf_lo(b.w)); v1[3] *= bf_hi(a.w) * __builtin_amdgcn_rcpf(bf_hi(b.w)); } } while (0)
        MX_LOAD(0); MX_LOAD(1);
        MX_COMP(0); asm volatile("" ::: "memory"); MX_LOAD(2);
        MX_COMP(1); asm volatile("" ::: "memory"); MX_LOAD(3);
        MX_COMP(2); asm volatile("" ::: "memory");
        MX_COMP(3); asm volatile("" ::: "memory");
#undef MX_LOAD
#undef MX_COMP
    }
    __device__ __forceinline__ void operator()(const f32x4 (&acc)[2][2][4][2], const Unit& u, int wr, int wc, int fr, int fq) const {
        const int row0 = u.pm * BM + wr * 64 + fr, col0 = u.pn * BM + wc * 32 + 8 * fq;
        u32x4 gb[2][4][2];
#pragma unroll
        for (int ai = 0; ai < 2; ++ai)
#pragma unroll
            for (int m = 0; m < 4; ++m)
#pragma unroll
                for (int bj = 0; bj < 2; ++bj) gb[ai][m][bj] = *(const u32x4*)(GB + (size_t)(row0 + ai * HALF + m * 16) * 2048 + col0 + bj * HALF);
#pragma unroll
        for (int ai = 0; ai < 2; ++ai)
#pragma unroll
            for (int m = 0; m < 4; ++m)
#pragma unroll
                for (int bj = 0; bj < 2; ++bj) { const u32x4 g = gb[ai][m][bj]; f32x4 v0 = acc[ai][bj][m][0], v1 = acc[ai][bj][m][1];
                    v0[0] *= bf_lo(g.x); v0[1] *= bf_hi(g.x); v0[2] *= bf_lo(g.y); v0[3] *= bf_hi(g.y); v1[0] *= bf_lo(g.z); v1[1] *= bf_hi(g.z); v1[2] *= bf_lo(g.w); v1[3] *= bf_hi(g.w);
                    *(u32x4*)(MIX + (size_t)(row0 + ai * HALF + m * 16) * 2048 + col0 + bj * HALF) = pack8(v0, v1); }
        asm volatile("" ::: "memory");
    }
};
template <bool SS> struct EpiResid {
    static constexpr bool PERM = true, AFTER_DRAIN = false; static constexpr int SEAM_VMOPS = 16;
    const bf16_t* XI; bf16_t* XO; float* SSP;
    __device__ __forceinline__ void operator()(const f32x4 (&acc)[2][2][4][2], const Unit& u, int wr, int wc, int fr, int fq) const {
        const int row0 = u.pm * BM + wr * 64 + fr, col0 = u.pn * BM + wc * 32 + 8 * fq;
        u32x4 xin[2][4][2];
#pragma unroll
        for (int ai = 0; ai < 2; ++ai)
#pragma unroll
            for (int m = 0; m < 4; ++m)
#pragma unroll
                for (int bj = 0; bj < 2; ++bj) xin[ai][m][bj] = *(const u32x4*)(XI + (size_t)(row0 + ai * HALF + m * 16) * 2048 + col0 + bj * HALF);
#pragma unroll
        for (int ai = 0; ai < 2; ++ai)
#pragma unroll
            for (int m = 0; m < 4; ++m) { const int row = row0 + ai * HALF + m * 16; const size_t off = (size_t)row * 2048 + col0; float s = 0.f;
#pragma unroll
                for (int bj = 0; bj < 2; ++bj) { const u32x4 xi = xin[ai][m][bj]; f32x4 o0 = acc[ai][bj][m][0], o1 = acc[ai][bj][m][1];
                    o0[0] += bf_lo(xi.x); o0[1] += bf_hi(xi.x); o0[2] += bf_lo(xi.y); o0[3] += bf_hi(xi.y); o1[0] += bf_lo(xi.z); o1[1] += bf_hi(xi.z); o1[2] += bf_lo(xi.w); o1[3] += bf_hi(xi.w);
                    s += ((o0[0] * o0[0] + o0[1] * o0[1]) + (o0[2] * o0[2] + o0[3] * o0[3])) + ((o1[0] * o1[0] + o1[1] * o1[1]) + (o1[2] * o1[2] + o1[3] * o1[3]));
                    *(u32x4*)(XO + off + bj * HALF) = pack8(o0, o1); }
                if (SS) { s += __shfl_xor(s, 16); s += __shfl_xor(s, 32); if (fq == 0) SSP[(size_t)row * 32 + u.pn * 4 + wc] = s; } }
        asm volatile("" ::: "memory");
    }
};
struct EpiGateUp {
    static constexpr bool PERM = true, AFTER_DRAIN = false; static constexpr int SEAM_VMOPS = 8;
    bf16_t* ACT; const PG8_LAS float* tab; int ldc;
    __device__ __forceinline__ void operator()(const f32x4 (&acc)[2][2][4][2], const Unit& u, int wr, int wc, int fr, int fq) const {
        const int col0 = u.pn * 128 + wc * 32 + 8 * fq;
#pragma unroll
        for (int ai = 0; ai < 2; ++ai)
#pragma unroll
            for (int m = 0; m < 4; ++m) { const int rl = ai * HALF + wr * 64 + m * 16 + fr; const float r = tab[rl];
                f32x4 a0, a1;
#pragma unroll
                for (int j = 0; j < 4; ++j) { a0[j] = 0.f; a1[j] = 0.f; }
                { const float rneg = r * -1.4426950408889634f, r2 = r * r;
                  a0 = (acc[ai][0][m][0] * acc[ai][1][m][0]) * r2 * sig4(acc[ai][0][m][0], rneg); a1 = (acc[ai][0][m][1] * acc[ai][1][m][1]) * r2 * sig4(acc[ai][0][m][1], rneg); }
                *(u32x4*)(ACT + (size_t)(u.pm * BM + rl) * ldc + col0) = pack8(a0, a1); }
    }
};
struct EpiPle {
    static constexpr bool PERM = true, AFTER_DRAIN = false; static constexpr int SEAM_VMOPS = 0;
    bf16_t* O;
    __device__ __forceinline__ void operator()(const f32x4 (&acc)[2][2][4][2], const Unit& u, int wr, int wc, int fr, int fq) const {
        const int row0 = u.pm * BM + wr * 64 + fr, col0 = u.pn * BM + wc * 32 + 8 * fq;
#pragma unroll
        for (int ai = 0; ai < 2; ++ai)
#pragma unroll
            for (int m = 0; m < 4; ++m)
#pragma unroll
                for (int bj = 0; bj < 2; ++bj) *(u32x4*)(O + (size_t)(row0 + ai * HALF + m * 16) * 2048 + col0 + bj * HALF) = pack8(acc[ai][bj][m][0], acc[ai][bj][m][1]);
    }
};
struct EpiPleGate {
    static constexpr bool PERM = true, AFTER_DRAIN = false; static constexpr int SEAM_VMOPS = 8;
    const bf16_t* XI; bf16_t* XO; const bf16_t* PLE; float* SSP;
    __device__ __forceinline__ void operator()(const f32x4 (&acc)[2][2][4][2], const Unit& u, int wr, int wc, int fr, int fq) const {
        const int row0 = u.pm * BM + wr * 64 + fr, col0 = u.pn * BM + wc * 32 + 8 * fq;
        u32x4 xin[2][2][2], pin[2][2][2];
#define PGT_LOAD(q) do { _Pragma("unroll") for (int m2 = 0; m2 < 2; ++m2) _Pragma("unroll") for (int bj = 0; bj < 2; ++bj) { const unsigned o_ = (unsigned)(row0 + ((q) >> 1) * HALF + (2 * ((q) & 1) + m2) * 16) * 2048u + (unsigned)(col0 + bj * HALF); \
            xin[(q) & 1][m2][bj] = *(const u32x4*)(XI + o_); pin[(q) & 1][m2][bj] = *(const u32x4*)(PLE + o_); } } while (0)
#define PGT_E(av, xw, pw, lo) ((lo ? bf_lo(xw) : bf_hi(xw)) + sigm(av) * (lo ? bf_lo(pw) : bf_hi(pw)))
#define PGT_COMP(q) do { _Pragma("unroll") for (int m2 = 0; m2 < 2; ++m2) { const int m = 2 * ((q) & 1) + m2; const int row = row0 + ((q) >> 1) * HALF + m * 16; const unsigned off = (unsigned)row * 2048u + (unsigned)col0; float s = 0.f; \
            _Pragma("unroll") for (int bj = 0; bj < 2; ++bj) { const f32x4 a0 = acc[(q) >> 1][bj][m][0], a1 = acc[(q) >> 1][bj][m][1]; const u32x4 xi = xin[(q) & 1][m2][bj], pl = pin[(q) & 1][m2][bj]; f32x4 o0, o1; \
                o0[0] = PGT_E(a0[0], xi.x, pl.x, true); o0[1] = PGT_E(a0[1], xi.x, pl.x, false); o0[2] = PGT_E(a0[2], xi.y, pl.y, true); o0[3] = PGT_E(a0[3], xi.y, pl.y, false); \
                o1[0] = PGT_E(a1[0], xi.z, pl.z, true); o1[1] = PGT_E(a1[1], xi.z, pl.z, false); o1[2] = PGT_E(a1[2], xi.w, pl.w, true); o1[3] = PGT_E(a1[3], xi.w, pl.w, false); \
                s += ((o0[0] * o0[0] + o0[1] * o0[1]) + (o0[2] * o0[2] + o0[3] * o0[3])) + ((o1[0] * o1[0] + o1[1] * o1[1]) + (o1[2] * o1[2] + o1[3] * o1[3])); \
                *(u32x4*)(XO + off + bj * HALF) = pack8(o0, o1); } \
            s += __shfl_xor(s, 16); s += __shfl_xor(s, 32); if (fq == 0) SSP[(size_t)row * 32 + u.pn * 4 + wc] = s; } } while (0)
        PGT_LOAD(0); PGT_LOAD(1);
        PGT_COMP(0); asm volatile("" ::: "memory"); PGT_LOAD(2);
        PGT_COMP(1); asm volatile("" ::: "memory"); PGT_LOAD(3);
        PGT_COMP(2); asm volatile("" ::: "memory");
        PGT_COMP(3); asm volatile("" ::: "memory");
#undef PGT_LOAD
#undef PGT_E
#undef PGT_COMP
    }
};

struct EpiNull {
    static constexpr bool PERM = true, AFTER_DRAIN = false; static constexpr int SEAM_VMOPS = 0;
    __device__ __forceinline__ void operator()(const f32x4 (&acc)[2][2][4][2], const Unit& u, int wr, int wc, int fr, int fq) const {
#pragma unroll
        for (int ai = 0; ai < 2; ++ai)
#pragma unroll
            for (int bj = 0; bj < 2; ++bj)
#pragma unroll
                for (int m = 0; m < 4; ++m)
#pragma unroll
                    for (int n = 0; n < 2; ++n) asm volatile("" :: "v"(acc[ai][bj][m][n]));
    }
};
struct SameTileOrder { int n; __device__ __forceinline__ bool next(int i, Unit& u) const { if (i >= n) return false; u.pm = 0; u.pn = 0; return true; }
    __device__ __forceinline__ void a_ready(const Unit&) const {} __device__ __forceinline__ void done(const Unit&) const {} };
template <class Epi, class Sched, bool ALIGN_EPI = false, bool SP2 = false, bool DUAL = false>
__device__ __forceinline__ void gemm_phase(PG8_LAS unsigned char* lds, const Gemm g, const Sched& S, const Epi& E) {
    int tid_ = threadIdx.x; asm volatile("" : "+v"(tid_));
    const int tid = tid_, wid = __builtin_amdgcn_readfirstlane(tid >> 6), lane = tid & 63, wr = wid >> 2, wc = wid & 3, fr = lane & 15, fq = lane >> 4;
    const int K = g.K, nt = K / BK;
    unsigned voffA[2], voffB[2];
#pragma unroll
    for (int i = 0; i < 2; ++i) { int R, C; stage_rc(tid * 16 + i * 8192, R, C); const int Rb = Epi::PERM ? ((R & ~31) + perm32(R & 31)) : R;
        voffA[i] = (unsigned)(R * K + C) * 2u; voffB[i] = (unsigned)(Rb * K + C) * 2u; }
    const size_t kstep = (size_t)(BK * 2);
    const size_t hstep = (size_t)HALF * K * 2;
    const size_t tstep = 2 * hstep;
    const unsigned ldsw = (unsigned)wid * 1024u;
    const int aoff = lds_byte(wr * 64 + fr, fq * 8), boff = lds_byte(wc * 32 + fr, fq * 8);
#define PG8_SA(b, h) (((b) * 2 + (h)) * HTB)
#define PG8_SB(b, h) ((4 + (b) * 2 + (h)) * HTB)
#define PG8_STAGE(bufoff, gbase, voff) do { _Pragma("unroll") for (int _i = 0; _i < 2; ++_i) \
        __builtin_amdgcn_global_load_lds((const unsigned*)((const char*)(gbase) + (voff)[_i]), (PG8_LAS unsigned*)(lds + (bufoff) + ldsw + _i * 8192), 16, 0, 0); } while (0)
#define PG8_LDA(dst, b, h) do { _Pragma("unroll") for (int m = 0; m < 4; ++m) _Pragma("unroll") for (int k = 0; k < 2; ++k) dst[m][k] = *(const PG8_LAS bf16x8*)(lds + PG8_SA(b, h) + aoff + m * 2048 + k * 1024); } while (0)
#define PG8_LDB(dst, b, h) do { _Pragma("unroll") for (int n = 0; n < 2; ++n) _Pragma("unroll") for (int k = 0; k < 2; ++k) dst[n][k] = *(const PG8_LAS bf16x8*)(lds + PG8_SB(b, h) + boff + n * 2048 + k * 1024); } while (0)
#define PG8_MMA(ai, bj, At, Bt) do { __builtin_amdgcn_s_setprio(1); _Pragma("unroll") for (int m = 0; m < 4; ++m) _Pragma("unroll") for (int n = 0; n < 2; ++n) _Pragma("unroll") for (int k = 0; k < 2; ++k) \
        acc[ai][bj][m][n] = __builtin_amdgcn_mfma_f32_16x16x32_bf16(Bt[n][k], At[m][k], acc[ai][bj][m][n], 0, 0, 0); __builtin_amdgcn_s_setprio(0); } while (0)
#define PG8_WAIT_V(n) asm volatile("s_waitcnt vmcnt(" #n ")" ::: "memory")
#define PG8_WAIT_VI(n) asm volatile("s_waitcnt vmcnt(%0)" :: "i"(n) : "memory")
#define PG8_WAIT_L(n) asm volatile("s_waitcnt lgkmcnt(" #n ")" ::: "memory")
#define PG8_BAR __builtin_amdgcn_s_barrier()
#define PG8_SCHED __builtin_amdgcn_sched_barrier(0)
    Unit cur, nxt; int ui = 0;
    if (!S.next(0, cur)) return;
    f32x4 acc[2][2][4][2];
#pragma unroll
    for (int a = 0; a < 2; ++a)
#pragma unroll
        for (int b = 0; b < 2; ++b)
#pragma unroll
            for (int m = 0; m < 4; ++m)
#pragma unroll
                for (int n = 0; n < 2; ++n) acc[a][b][m][n] = (f32x4){0.f, 0.f, 0.f, 0.f};
    bf16x8 At[4][2], B0[2][2], B1[2][2];
    const char* cA = (const char*)g.A + (size_t)cur.pm * tstep; const char* cB = (const char*)g.Bt + (size_t)cur.pn * tstep;
    S.a_ready(cur);
    if constexpr (SP2) {
        PG8_STAGE(PG8_SB(0, 0), cB, voffB); PG8_STAGE(PG8_SB(0, 1), cB + hstep, voffB); PG8_STAGE(PG8_SA(0, 0), cA, voffA); PG8_STAGE(PG8_SA(0, 1), cA + hstep, voffA);
        if (wr == 1) PG8_BAR;
        PG8_WAIT_V(2); PG8_BAR;
        PG8_STAGE(PG8_SB(1, 0), cB + kstep, voffB); PG8_STAGE(PG8_SA(1, 0), cA + kstep, voffA); PG8_STAGE(PG8_SB(1, 1), cB + hstep + kstep, voffB);
        PG8_WAIT_V(6); PG8_BAR;
    } else {
        PG8_STAGE(PG8_SB(0, 0), cB, voffB); PG8_STAGE(PG8_SA(0, 0), cA, voffA); PG8_STAGE(PG8_SB(0, 1), cB + hstep, voffB); PG8_STAGE(PG8_SA(0, 1), cA + hstep, voffA);
        if (wr == 1) PG8_BAR;
        PG8_WAIT_V(4); PG8_BAR;
        PG8_STAGE(PG8_SB(1, 0), cB + kstep, voffB); PG8_STAGE(PG8_SA(1, 0), cA + kstep, voffA); PG8_STAGE(PG8_SB(1, 1), cB + hstep + kstep, voffB);
        PG8_WAIT_V(6); PG8_BAR;
    }
    for (;;) {
        const bool has_next = S.next(DUAL ? ((ui + 1) >> 1) : (ui + 1), nxt);
        const bf16_t* nAm = (DUAL && ((ui + 1) & 1)) ? g.A2 : g.A; const bf16_t* nBm = (DUAL && ((ui + 1) & 1)) ? g.Bt2 : g.Bt;
        const char* nA = has_next ? (const char*)nAm + (size_t)nxt.pm * tstep : cA; const char* nB = has_next ? (const char*)nBm + (size_t)nxt.pn * tstep : cB;
        for (int t = 0; t < nt; t += 2) {
            const bool last = (t == nt - 2);
            const char* a1 = cA + (size_t)(t + 1) * kstep;
            const char* a2 = last ? nA : cA + (size_t)(t + 2) * kstep; const char* b2 = last ? nB : cB + (size_t)(t + 2) * kstep;
            const char* a3 = a2 + kstep; const char* b3 = b2 + kstep;
            if (last && has_next) S.a_ready(nxt);
            if constexpr (SP2) {
            int rl = __builtin_amdgcn_readfirstlane((Epi::SEAM_VMOPS > 0 && t == 0 && ui > 0) ? 1 : 0); if (Epi::SEAM_VMOPS > 0) asm volatile("" : "+s"(rl));
            PG8_LDB(B0, 0, 0); PG8_LDB(B1, 0, 1); PG8_SCHED; PG8_LDA(At, 0, 0); PG8_STAGE(PG8_SA(1, 1), a1 + hstep, voffA);
            if (Epi::SEAM_VMOPS > 0 && rl) PG8_WAIT_VI(8 + Epi::SEAM_VMOPS); else PG8_WAIT_V(8);
            PG8_WAIT_L(0); PG8_BAR; PG8_MMA(0, 0, At, B0); PG8_MMA(0, 1, At, B1); PG8_BAR; PG8_SCHED;
            PG8_LDA(At, 0, 1); PG8_STAGE(PG8_SB(0, 0), b2, voffB); PG8_STAGE(PG8_SB(0, 1), b2 + hstep, voffB); PG8_STAGE(PG8_SA(0, 0), a2, voffA);
            if (Epi::SEAM_VMOPS > 0 && rl) PG8_WAIT_VI(8 + Epi::SEAM_VMOPS); else PG8_WAIT_V(8);
            PG8_WAIT_L(0); PG8_BAR; PG8_MMA(1, 0, At, B0); PG8_MMA(1, 1, At, B1); PG8_BAR; PG8_SCHED;
            PG8_LDB(B0, 1, 0); PG8_LDB(B1, 1, 1); PG8_SCHED; PG8_LDA(At, 1, 0); PG8_STAGE(PG8_SA(0, 1), a2 + hstep, voffA);
            PG8_WAIT_V(8); PG8_WAIT_L(0); PG8_BAR; PG8_MMA(0, 0, At, B0); PG8_MMA(0, 1, At, B1); PG8_BAR; PG8_SCHED;
            PG8_LDA(At, 1, 1); PG8_STAGE(PG8_SB(1, 0), b3, voffB); PG8_STAGE(PG8_SB(1, 1), b3 + hstep, voffB); PG8_STAGE(PG8_SA(1, 0), a3, voffA);
            PG8_WAIT_V(8); PG8_WAIT_L(0); PG8_BAR; PG8_MMA(1, 0, At, B0); PG8_MMA(1, 1, At, B1); PG8_BAR; PG8_SCHED;
            } else {
            PG8_LDB(B0, 0, 0); PG8_SCHED; PG8_LDA(At, 0, 0); PG8_STAGE(PG8_SA(1, 1), a1 + hstep, voffA);
            PG8_WAIT_L(8); PG8_BAR; PG8_WAIT_L(0); PG8_MMA(0, 0, At, B0); PG8_BAR; PG8_SCHED;
            PG8_LDB(B1, 0, 1); PG8_STAGE(PG8_SB(0, 0), b2, voffB);
            PG8_BAR; PG8_WAIT_L(0); PG8_MMA(0, 1, At, B1); PG8_BAR;
            PG8_LDA(At, 0, 1); PG8_STAGE(PG8_SA(0, 0), a2, voffA);
            PG8_BAR; PG8_WAIT_L(0); PG8_MMA(1, 0, At, B0); PG8_BAR; PG8_SCHED;
            PG8_STAGE(PG8_SB(0, 1), b2 + hstep, voffB);
            PG8_WAIT_V(6); PG8_BAR; PG8_MMA(1, 1, At, B1); PG8_BAR;
            PG8_LDB(B0, 1, 0); PG8_SCHED; PG8_LDA(At, 1, 0); PG8_STAGE(PG8_SA(0, 1), a2 + hstep, voffA);
            PG8_WAIT_L(8); PG8_BAR; PG8_WAIT_L(0); PG8_MMA(0, 0, At, B0); PG8_BAR; PG8_SCHED;
            PG8_LDB(B1, 1, 1); PG8_STAGE(PG8_SB(1, 0), b3, voffB);
            PG8_BAR; PG8_WAIT_L(0); PG8_MMA(0, 1, At, B1); PG8_BAR;
            PG8_LDA(At, 1, 1); PG8_STAGE(PG8_SA(1, 0), a3, voffA);
            PG8_BAR; PG8_WAIT_L(0); PG8_MMA(1, 0, At, B0); PG8_BAR; PG8_SCHED;
            PG8_STAGE(PG8_SB(1, 1), b3 + hstep, voffB);
            PG8_WAIT_V(6); PG8_BAR; PG8_MMA(1, 1, At, B1); PG8_BAR;
            }
        }
        if constexpr (ALIGN_EPI) { if (wr == 0) PG8_BAR; }
        const bool keep = DUAL && !(ui & 1);
        if constexpr (DUAL) { if (keep) E.mid(acc, cur, wr, wc, fr, fq); else { E(acc, cur, wr, wc, fr, fq); S.done(cur); } }
        else if constexpr (!Epi::AFTER_DRAIN) { E(acc, cur, wr, wc, fr, fq); S.done(cur); }
        if (!has_next) break;
        if (!keep) {
#pragma unroll
        for (int a = 0; a < 2; ++a)
#pragma unroll
            for (int b = 0; b < 2; ++b)
#pragma unroll
                for (int m = 0; m < 4; ++m)
#pragma unroll
                    for (int n = 0; n < 2; ++n) acc[a][b][m][n] = (f32x4){0.f, 0.f, 0.f, 0.f};
        }
        cur = nxt; cA = nA; cB = nB; ++ui;
        if constexpr (ALIGN_EPI) { if (wr == 1) PG8_BAR; }
    }
    PG8_WAIT_V(0);
    if constexpr (!ALIGN_EPI) { if (wr == 0) PG8_BAR; }
    PG8_BAR;
    if constexpr (Epi::AFTER_DRAIN) { E.fused(acc, cur, wr, wc, fr, fq, lds, wid, lane); S.done(cur); }
#undef PG8_SA
#undef PG8_SB
#undef PG8_STAGE
#undef PG8_LDA
#undef PG8_LDB
#undef PG8_MMA
#undef PG8_WAIT_V
#undef PG8_WAIT_VI
#undef PG8_WAIT_L
#undef PG8_BAR
#undef PG8_SCHED
}
}
#ifndef PG8_SP2
#define PG8_SP2 true
#endif
#ifndef PG8_ALIGN
#define PG8_ALIGN true
#endif
constexpr int NWAVES = 8;
#ifndef MK_N_LAUNCHES
#define MK_N_LAUNCHES 1
#endif
constexpr int N_PHASES = 10;
constexpr int N_LAUNCHES = MK_N_LAUNCHES;

constexpr int BATCH = 8, SEQ = 2048, DM = 2048, M = BATCH * SEQ;
constexpr int NH = 8, HD = 128, AW = 1024, MBLK = 256, NBLK = SEQ / MBLK;
constexpr int DFF = 5632, PLED = 256, INW = 11264;
constexpr float NORM_EPS = 1e-6f;

constexpr size_t MiB = 1u << 20;
constexpr size_t WS_CTL = 0, CTL_ZERO_BYTES = 32768;
constexpr size_t WS_RSTD0 = 1 * MiB, WS_LB = WS_RSTD0 + 65536, WS_TB = WS_LB + 4096, WS_KMEAN = WS_RSTD0 + 131072;
constexpr size_t WS_SS1 = 2 * MiB, WS_SS3 = 4 * MiB;
constexpr size_t WS_WIN = 8 * MiB, WS_WGU = 52 * MiB, WS_WDN = 96 * MiB, WS_WOUT = 118 * MiB, WS_WPG = 126 * MiB, WS_WA = 134 * MiB, WS_WB = 138 * MiB, WS_WPLE = 142 * MiB;
constexpr size_t WS_PB = 143 * MiB;
constexpr size_t WS_RA = 152 * MiB;
constexpr size_t WS_ARENA = 216 * MiB, ARENA_STRIDE = 36 * MiB;
constexpr size_t AO_Q = 0, AO_K = 4 * MiB, AO_V = 8 * MiB, AO_QB = 12 * MiB, AO_F = 16 * MiB, AO_IB = 24 * MiB, AO_SG = 28 * MiB, AO_YB = 32 * MiB;
constexpr size_t AO_YA = AO_Q, AO_MIX = AO_K, AO_ACT = AO_QB, AO_PLE = AO_QB, AO_X3B = AO_PLE + 8 * MiB, WS_END = WS_ARENA + 8 * ARENA_STRIDE;
static_assert(AO_ACT + (size_t)SEQ * DFF * 2 <= ARENA_STRIDE && AO_MIX + (size_t)SEQ * DM * 2 <= AO_QB && AO_X3B + (size_t)SEQ * DM * 2 <= ARENA_STRIDE && WS_RA + (size_t)M * DM * 2 <= WS_ARENA && WS_END <= 504 * MiB, "d_ws map");
constexpr int CW_GRP = 512, CW_GRPX = 1536, CW_LATE = 2560, CW_PNL = 3072;
constexpr int CW_BAR = 4096;

constexpr int RING_OFF = 0, RING_BYTES = 131072;
constexpr int LDSCTL_OFF = RING_BYTES, MISC_OFF = LDSCTL_OFF + 320, TAB_OFF = LDSCTL_OFF + 1024;
constexpr int LDS_BYTES = 147456;
static_assert(TAB_OFF + 1024 <= LDS_BYTES, "LDS map");
#define GAS __attribute__((address_space(1)))
#define LAS __attribute__((address_space(3)))
typedef unsigned short bf16;
typedef unsigned v4u __attribute__((ext_vector_type(4)));
typedef float f32x4 __attribute__((ext_vector_type(4)));
typedef short bf16x8 __attribute__((ext_vector_type(8)));
typedef GAS unsigned gu32;
typedef GAS unsigned long long gu64;
#define RLX_AGENT __ATOMIC_RELAXED, __HIP_MEMORY_SCOPE_AGENT
#define LDS_WAIT() asm volatile("s_waitcnt lgkmcnt(0)" ::: "memory")
#define VM_WAIT() asm volatile("s_waitcnt vmcnt(0)" ::: "memory")
__device__ __forceinline__ unsigned long long rt() { return __builtin_amdgcn_s_memrealtime(); }
__device__ __forceinline__ unsigned f2bf(float f) { unsigned u = __builtin_bit_cast(unsigned, f); return (u + 0x7fffu + ((u >> 16) & 1u)) >> 16; }
__device__ __forceinline__ unsigned pk2(float lo, float hi) { unsigned r; asm volatile("v_cvt_pk_bf16_f32 %0, %1, %2" : "=v"(r) : "v"(lo), "v"(hi)); return r; }

#define XB_TMO      128
#define XB_XCNT(j)  (256  + 64 * (j))
#define XB_XSUB(j)  (1280 + 64 * (j))
#define XB_XGEN(j)  (2304 + 64 * (j))
#define XB_TOP      3328
#define XB_TOPGEN   3392
#define XCD_BAR_WORDS 3456
#define XB_SPIN_CAP (1u << 18)

__device__ __forceinline__ unsigned xb_ld(unsigned* p)              { return __hip_atomic_load(p, __ATOMIC_RELAXED, __HIP_MEMORY_SCOPE_AGENT); }
__device__ __forceinline__ unsigned xb_add(unsigned* p, unsigned v) { return __hip_atomic_fetch_add(p, v, __ATOMIC_RELAXED, __HIP_MEMORY_SCOPE_AGENT); }
__device__ __forceinline__ unsigned xb_xcc_id() { return (unsigned)__builtin_amdgcn_s_getreg((3 << 11) | 20) & 0xFu; }
#define XB_SPIN(cond, bar) do { unsigned _sp = 0; while (cond) { __builtin_amdgcn_s_sleep(1); \
    if ((++_sp & 255u) == 0u) { if (xb_ld(&(bar)[XB_TMO])) break; if (_sp > XB_SPIN_CAP) { atomicAdd(&(bar)[XB_TMO], 1u); break; } } } } while (0)

struct XcdBarrier {
    unsigned* bar; unsigned x;
    volatile LAS unsigned* st;
};

__device__ __forceinline__ XcdBarrier xcd_barrier_post(unsigned* bar, volatile LAS unsigned* st) {
    XcdBarrier b; b.bar = bar; b.x = xb_xcc_id(); b.st = st;
    if (threadIdx.x == 0) (void)xb_add(&bar[XB_XCNT(b.x)], 1u);
    return b;
}
__device__ __forceinline__ void xcd_barrier_complete(unsigned* bar, unsigned x, unsigned& nloc, unsigned& nx) {
    const unsigned G = gridDim.x * gridDim.y * gridDim.z;
    unsigned sum, cnt, mine, sp = 0u;
    for (;;) {
        sum = 0u; cnt = 0u; mine = 0u;
#pragma unroll
        for (unsigned j = 0; j < 16; ++j) { const unsigned c = xb_ld(&bar[XB_XCNT(j)]); sum += c; cnt += (c > 0u) ? 1u : 0u; mine = (j == x) ? c : mine; }
        if (sum == G) break;
        __builtin_amdgcn_s_sleep(1);
        if ((++sp & 255u) == 0u) { if (xb_ld(&bar[XB_TMO])) break; if (sp > XB_SPIN_CAP) { atomicAdd(&bar[XB_TMO], 1u); break; } }
    }
    nloc = mine > 0u ? mine : 1u; nx = cnt > 0u ? cnt : 1u;
}

__device__ __forceinline__ void xcd_barrier(const XcdBarrier& b) {
    asm volatile("s_waitcnt vmcnt(0)" ::: "memory");
    __syncthreads();
    if (threadIdx.x == 0) {
        unsigned* bar = b.bar;
        __builtin_amdgcn_s_waitcnt(0);
        unsigned nloc = b.st[0], nx = b.st[1];
        if (nloc == 0u) { xcd_barrier_complete(bar, b.x, nloc, nx); b.st[0] = nloc; b.st[1] = nx; }
        const unsigned old = xb_add(&bar[XB_XSUB(b.x)], 1u);
        const unsigned gen = old / nloc;
        if (old + 1u == (gen + 1u) * nloc) {
            __builtin_amdgcn_fence(__ATOMIC_RELEASE, "agent");
            asm volatile("s_waitcnt vmcnt(0)" ::: "memory");
            const unsigned og = xb_add(&bar[XB_TOP], 1u);
            const unsigned tg = og / nx;
            if (og + 1u == (tg + 1u) * nx) xb_add(&bar[XB_TOPGEN], 1u);
            else XB_SPIN(xb_ld(&bar[XB_TOPGEN]) == tg, bar);
            __builtin_amdgcn_fence(__ATOMIC_ACQUIRE, "agent");
            xb_add(&bar[XB_XGEN(b.x)], 1u);
            asm volatile("s_waitcnt vmcnt(0)" ::: "memory");
        } else {
            XB_SPIN(xb_ld(&bar[XB_XGEN(b.x)]) == gen, bar);
            __builtin_amdgcn_fence(__ATOMIC_ACQUIRE, "agent");
            asm volatile("s_waitcnt vmcnt(0)" ::: "memory");
        }
    }
    __syncthreads();
}

struct GrpBar { unsigned* cnt; unsigned tgt, n; int light; };
__device__ __forceinline__ void grp_barrier(GrpBar& g, unsigned* bar, unsigned* late) {
    asm volatile("s_waitcnt vmcnt(0)" ::: "memory");
    __syncthreads();
    g.tgt += g.n;
    if (threadIdx.x == 0) {
        __builtin_amdgcn_s_waitcnt(0);
        if (!g.light) { __builtin_amdgcn_fence(__ATOMIC_RELEASE, "agent"); asm volatile("s_waitcnt vmcnt(0)" ::: "memory"); }
        if (late && !g.light) (void)xb_add(late, 1u);
        (void)xb_add(g.cnt, 1u);
        XB_SPIN(xb_ld(g.cnt) < g.tgt, bar);
        __builtin_amdgcn_fence(__ATOMIC_ACQUIRE, "agent");
        asm volatile("s_waitcnt vmcnt(0)" ::: "memory");
        if (late && g.light && (blockIdx.x >> 3) == 8) { __builtin_amdgcn_fence(__ATOMIC_RELEASE, "agent"); asm volatile("s_waitcnt vmcnt(0)" ::: "memory"); (void)xb_add(late, g.n); }
    }
    __syncthreads();
}
__device__ __forceinline__ void late_wait(unsigned* late, unsigned n, unsigned* bar) {
    if (threadIdx.x == 0) { XB_SPIN(xb_ld(late) < n, bar); __builtin_amdgcn_fence(__ATOMIC_ACQUIRE, "agent"); asm volatile("s_waitcnt vmcnt(0)" ::: "memory"); }
    __syncthreads();
}
__device__ __forceinline__ float wave_sum(float v) {
#pragma unroll
    for (int o = 1; o < 64; o <<= 1) v += __shfl_xor(v, o);
    return v;
}
namespace att {
typedef short s16x4 __attribute__((ext_vector_type(4)));
typedef float f32x16 __attribute__((ext_vector_type(16)));
constexpr int PITCH = 1024, SHM_K = 16384, SHM_V = 16384;
constexpr int L_V = 0, L_K = 2 * SHM_V, L_WS = L_K + 2 * SHM_K, L_KM = L_WS + 8 * 256, L_SEL = L_KM + 4096, L_TB = L_SEL + 1024, L_END = L_TB + 1024;
constexpr float SCALE = 0.08838834764831845f;
#define KSWZ(row, colB) ((row) * 256 + ((colB) ^ (((row) & 7) << 4)))
#define SBAR() __builtin_amdgcn_sched_barrier(0)
__device__ __forceinline__ int v_st(int k, int c) { const int kk = (k & ~0xC) | ((k & 4) << 1) | ((k & 8) >> 1); return ((kk >> 3) * 4 + (c >> 5)) * 512 + ((kk & 7) * 32 + (c & 31)) * 2; }
__device__ __forceinline__ int v_rd_base(int lane) { return ((lane & 3) << 3) | (((lane >> 2) & 3) << 6) | (((lane >> 4) & 1) << 5) | (((lane >> 5) & 1) << 8); }
constexpr int v_rd_off(int d0, int ks, int half) { return d0 * 512 + ks * 4096 + half * 2048; }
__device__ __forceinline__ int crow(int r, int hi) { return (r & 3) + 8 * (r >> 2) + 4 * hi; }
__device__ __forceinline__ unsigned cvtpk(float lo, float hi) { unsigned r; asm volatile("v_cvt_pk_bf16_f32 %0, %1, %2" : "=v"(r) : "v"(lo), "v"(hi)); return r; }

constexpr float THR = 8.f;
__device__ __forceinline__ void partialSM(f32x16& p0, f32x16& p1, float& m_reg, float& mn, float& alpha) {
    float pmax = p0[0];
#pragma unroll
    for (int r = 1; r < 16; ++r) pmax = fmaxf(pmax, p0[r]);
#pragma unroll
    for (int r = 0; r < 16; ++r) pmax = fmaxf(pmax, p1[r]);
    { auto rr = __builtin_amdgcn_permlane32_swap(__float_as_uint(pmax), __float_as_uint(pmax), false, false);
      pmax = fmaxf(__uint_as_float(rr[0]), __uint_as_float(rr[1])); }
    constexpr float C2 = 1.4426950408889634f * SCALE;
    if (__builtin_expect(__all((pmax - m_reg) * SCALE <= THR), 1)) { mn = m_reg; alpha = 1.f; }
    else { mn = fmaxf(m_reg, pmax); alpha = __builtin_amdgcn_exp2f((m_reg - mn) * C2); m_reg = mn; }
    const float mnL = -mn * C2;
#pragma unroll
    for (int r = 0; r < 16; ++r) p0[r] = fmaf(p0[r], C2, mnL);
#pragma unroll
    for (int r = 0; r < 16; ++r) p1[r] = fmaf(p1[r], C2, mnL);
#pragma unroll
    for (int r = 0; r < 16; ++r) p0[r] = __builtin_amdgcn_exp2f(p0[r]);
}
__device__ __forceinline__ void pack_p(const f32x16& p0, const f32x16& p1, bf16x8& pa0, bf16x8& pa1, bf16x8& pa2, bf16x8& pa3) {
#define PK4(P, B_, OUT) do { unsigned a0 = cvtpk(P[B_+0], P[B_+1]), a1 = cvtpk(P[B_+2], P[B_+3]);                          \
        unsigned b0 = cvtpk(P[B_+4], P[B_+5]), b1 = cvtpk(P[B_+6], P[B_+7]);                                             \
        auto r0 = __builtin_amdgcn_permlane32_swap(a0, b0, false, false); auto r1 = __builtin_amdgcn_permlane32_swap(a1, b1, false, false); \
        v4u w = {r0[0], r1[0], r0[1], r1[1]}; OUT = *reinterpret_cast<bf16x8*>(&w); } while (0)
    PK4(p0, 0, pa0); PK4(p0, 8, pa1); PK4(p1, 0, pa2); PK4(p1, 8, pa3);
#undef PK4
}
__device__ __forceinline__ void finishSM(f32x16& p0, f32x16& p1, float alpha, float& l_reg, bf16x8& pa0, bf16x8& pa1, bf16x8& pa2, bf16x8& pa3) {
#pragma unroll
    for (int r = 0; r < 16; ++r) p1[r] = __builtin_amdgcn_exp2f(p1[r]);
    float ps = 0;
#pragma unroll
    for (int r = 0; r < 16; ++r) ps += p0[r];
#pragma unroll
    for (int r = 0; r < 16; ++r) ps += p1[r];
    { auto rr = __builtin_amdgcn_permlane32_swap(__float_as_uint(ps), __float_as_uint(ps), false, false);
      ps = __uint_as_float(rr[0]) + __uint_as_float(rr[1]); }
    l_reg = l_reg * alpha + ps;
    pack_p(p0, p1, pa0, pa1, pa2, pa3);
}
__device__ __forceinline__ void qkt(f32x16& p0, f32x16& p1, const LAS char* Kb, int r32, int hi, const bf16x8* qr) {
    p0 = f32x16{}; p1 = f32x16{};
    const LAS char* kb[4];
#pragma unroll
    for (int dd = 0; dd < 4; ++dd) kb[dd] = Kb + KSWZ(r32, (dd * 16 + hi * 8) * 2);
#pragma unroll
    for (int d0 = 0; d0 < 8; ++d0) { const LAS char* a = kb[d0 & 3] + (d0 >> 2) * 128;
        const bf16x8 b0 = *reinterpret_cast<const LAS bf16x8*>(a);
        const bf16x8 b1 = *reinterpret_cast<const LAS bf16x8*>(a + 32 * 256);
        p0 = __builtin_amdgcn_mfma_f32_32x32x16_bf16(b0, qr[d0], p0, 0, 0, 0);
        p1 = __builtin_amdgcn_mfma_f32_32x32x16_bf16(b1, qr[d0], p1, 0, 0, 0); }
}
__device__ __forceinline__ void pv_tile(f32x16* o, int vb0, bf16x8 pa0, bf16x8 pa1, bf16x8 pa2, bf16x8 pa3) {
#define TRRD(dst, off) asm volatile("ds_read_b64_tr_b16 %0, %1 offset:%2" : "=&v"(dst) : "v"(vb0), "i"(off) : "memory")
#define PV_D0(d0) do { s16x4 l0, l1, l2, l3, h0, h1, h2, h3; constexpr int b_ = v_rd_off(d0, 0, 0); \
        TRRD(l0, b_); TRRD(h0, b_ + 2048); TRRD(l1, b_ + 4096); TRRD(h1, b_ + 6144); TRRD(l2, b_ + 8192); TRRD(h2, b_ + 10240); TRRD(l3, b_ + 12288); TRRD(h3, b_ + 14336); \
        asm volatile("s_waitcnt lgkmcnt(0)" ::: "memory"); SBAR();   \
        o[d0] = __builtin_amdgcn_mfma_f32_32x32x16_bf16(pa0, (bf16x8){l0[0], l0[1], l0[2], l0[3], h0[0], h0[1], h0[2], h0[3]}, o[d0], 0, 0, 0);   \
        o[d0] = __builtin_amdgcn_mfma_f32_32x32x16_bf16(pa1, (bf16x8){l1[0], l1[1], l1[2], l1[3], h1[0], h1[1], h1[2], h1[3]}, o[d0], 0, 0, 0);   \
        o[d0] = __builtin_amdgcn_mfma_f32_32x32x16_bf16(pa2, (bf16x8){l2[0], l2[1], l2[2], l2[3], h2[0], h2[1], h2[2], h2[3]}, o[d0], 0, 0, 0);   \
        o[d0] = __builtin_amdgcn_mfma_f32_32x32x16_bf16(pa3, (bf16x8){l3[0], l3[1], l3[2], l3[3], h3[0], h3[1], h3[2], h3[3]}, o[d0], 0, 0, 0); } while (0)
    PV_D0(0); PV_D0(1); PV_D0(2); PV_D0(3);
#undef PV_D0
#undef TRRD
}
__device__ __forceinline__ void attn_unit(LAS char* lds, int b, int h, int qb, const bf16* Qg, const bf16* Kg, const bf16* Vg, bf16* Og, const float* kmean, const float* tbh) {
    int tid_ = threadIdx.x; asm volatile("" : "+v"(tid_));
    const int tid = tid_, wid = __builtin_amdgcn_readfirstlane(tid >> 6), lane = tid & 63, r32 = lane & 31, hi = lane >> 5;
    LAS char* V_lds = lds + L_V; LAS char* K_lds = lds + L_K;
    LAS float* wsf = (LAS float*)(lds + L_WS) + wid * 64; LAS float* li_l = wsf; LAS float* al_l = wsf + 32;
    LAS float* KM = (LAS float*)(lds + L_KM); LAS int* SEL = (LAS int*)(lds + L_SEL); LAS float* TB = (LAS float*)(lds + L_TB);
    const size_t rowbase = (size_t)b * SEQ;
    __syncthreads();
    bf16x8 qr[8];
    { const bf16* qp = Qg + (rowbase + (size_t)qb * MBLK + wid * 32 + r32) * PITCH + h * HD + hi * 8;
#pragma unroll
      for (int d0 = 0; d0 < 8; ++d0) qr[d0] = *(const bf16x8*)(qp + d0 * 16); }
    const int sr = tid >> 4, sc8 = (tid & 15) * 8, vst0 = v_st(sr, sc8), vst1 = v_st(32 + sr, sc8), kws = KSWZ(sr, sc8 * 2);
    const bf16* Kh = Kg + rowbase * PITCH + h * HD + sc8; const bf16* Vh = Vg + rowbase * PITCH + h * HD + sc8;
    bf16x8 st_k0, st_k1, st_v0, st_v1;
#define ATT_LOAD(kb) do { st_k0 = *(const bf16x8*)(Kh + (size_t)((kb) + sr) * PITCH); st_k1 = *(const bf16x8*)(Kh + (size_t)((kb) + 32 + sr) * PITCH); \
                          st_v0 = *(const bf16x8*)(Vh + (size_t)((kb) + sr) * PITCH); st_v1 = *(const bf16x8*)(Vh + (size_t)((kb) + 32 + sr) * PITCH); } while (0)
#define ATT_WRITE(bf) do { *(LAS bf16x8*)(K_lds + (bf) * SHM_K + kws) = st_k0; *(LAS bf16x8*)(K_lds + (bf) * SHM_K + kws + 32 * 256) = st_k1; \
                           *(LAS bf16x8*)(V_lds + (bf) * SHM_V + vst0) = st_v0; *(LAS bf16x8*)(V_lds + (bf) * SHM_V + vst1) = st_v1; } while (0)
    ATT_LOAD(0);
    if (tid < 256) { const float* kp = kmean + (size_t)((b * NH + h) * NBLK + (tid >> 5)) * 256 + (tid & 31) * 4;
        *(LAS f32x4*)(KM + tid * 4) = (*(const f32x4*)kp + *(const f32x4*)(kp + 128)) * (1.0f / MBLK); }
    else if (tid < 256 + 129) TB[tid - 256] = tbh[tid - 256];
    __syncthreads();
    {
        const int row = tid >> 1, part = tid & 1;
        const bf16* qp = Qg + (rowbase + (size_t)qb * MBLK + row) * PITCH + h * HD;
        float a4[4] = {0.f, 0.f, 0.f, 0.f};
        if (qb > 3)
#pragma unroll 4
        for (int c = 0; c < 16; ++c) { const v4u qv = *(const v4u*)(qp + c * 8);
            const float q0 = __uint_as_float(qv.x << 16), q1 = __uint_as_float(qv.x & 0xffff0000u), q2 = __uint_as_float(qv.y << 16), q3 = __uint_as_float(qv.y & 0xffff0000u),
                        q4 = __uint_as_float(qv.z << 16), q5 = __uint_as_float(qv.z & 0xffff0000u), q6 = __uint_as_float(qv.w << 16), q7 = __uint_as_float(qv.w & 0xffff0000u);
#pragma unroll
            for (int nn = 0; nn < 4; ++nn) { const LAS float* km = KM + (2 * nn + part) * HD + c * 8; const f32x4 k0 = *(const LAS f32x4*)km, k1 = *(const LAS f32x4*)(km + 4);
                a4[nn] += (q0 * k0[0] + q1 * k0[1]) + (q2 * k0[2] + q3 * k0[3]) + (q4 * k1[0] + q5 * k1[1]) + (q6 * k1[2] + q7 * k1[3]); } }
        float sc[8];
#pragma unroll
        for (int nn = 0; nn < 4; ++nn) { const float ot = __shfl_xor(a4[nn], 1); sc[2 * nn] = part ? ot : a4[nn]; sc[2 * nn + 1] = part ? a4[nn] : ot; }
        int mask = 0;
        if (qb <= 3) mask = (1 << qb) - 1;
        else {
#pragma unroll
            for (int rd = 0; rd < 3; ++rd) { float best = -__builtin_inff(); int bi = 0;
#pragma unroll
                for (int n = 0; n < 8; ++n) { const bool ok = (n < qb) && !((mask >> n) & 1) && (sc[n] > best); best = ok ? sc[n] : best; bi = ok ? n : bi; }
                mask |= 1 << bi; } }
        if (part == 0) SEL[row] = mask;
    }
    ATT_WRITE(0);
    __syncthreads();
    const int selmask = SEL[wid * 32 + r32];
    if (wid >= 4) __builtin_amdgcn_s_setprio(1);
    const int qlo = qb * MBLK + wid * 32, qpos = qlo + r32;
    const int vbase = (int)(uintptr_t)(V_lds) + v_rd_base(lane);
    float m_reg = -1e30f, l_reg = 0.f; f32x16 o[4] = {};
    const int T = 4 * (qb + 1);
    const float NEG = -__builtin_inff();
    f32x16 pA0, pA1, pB0, pB1; float mnA, mnB, alA, alB; bf16x8 pa0, pa1, pa2, pa3;
#define ATT_ACT(t) ((((t) >> 2) == qb) ? ((t) * 64 <= qlo + 31) : (__any((selmask >> ((t) >> 2)) & 1) != 0))
#define ATT_QKT(P0_, P1_, t, KB) do { if (ATT_ACT(t)) qkt(P0_, P1_, K_lds + (KB) * SHM_K, r32, hi, qr); else { _Pragma("unroll") for (int r = 0; r < 16; ++r) { P0_[r] = NEG; P1_[r] = NEG; } } } while (0)
#define ATT_PV(t, VB) do { if (ATT_ACT(t)) pv_tile(o, vbase + (VB) * SHM_V, pa0, pa1, pa2, pa3); } while (0)
#define ATT_MASK(P0_, P1_, t) do { const int n_ = (t) >> 2, kb_ = (t) * 64; if (ATT_ACT(t)) { const bool rowsel = (n_ == qb) || ((selmask >> n_) & 1);                    \
        if (qlo - kb_ - 63 < 128) { const int dq = qpos - kb_ - 4 * hi;                                                                                          \
            _Pragma("unroll") for (int r = 0; r < 16; ++r) { const int c = (r & 3) + 8 * (r >> 2); const int rel0 = dq - c, rel1 = rel0 - 32;                      \
                const int i0 = rel0 < 0 ? 0 : (rel0 > 128 ? 128 : rel0), i1 = rel1 < 0 ? 0 : (rel1 > 128 ? 128 : rel1);                                         \
                const float v0 = P0_[r] + TB[i0], v1 = P1_[r] + TB[i1];                                                                                           \
                P0_[r] = (rowsel && rel0 >= 0) ? v0 : NEG; P1_[r] = (rowsel && rel1 >= 0) ? v1 : NEG;                                                             \
                if ((r & 3) == 3) asm volatile("" ::: "memory"); }                                                                                                \
        } else { _Pragma("unroll") for (int r = 0; r < 16; ++r) { P0_[r] = rowsel ? P0_[r] : NEG; P1_[r] = rowsel ? P1_[r] : NEG; } } } } while (0)
#define ATT_RESC(a) do { if (__any((a) < 1.f)) { if (hi == 0) al_l[r32] = (a); asm volatile("s_waitcnt lgkmcnt(0)" ::: "memory");                                \
        _Pragma("unroll") for (int d_ = 0; d_ < 4; ++d_) _Pragma("unroll") for (int r = 0; r < 16; ++r) o[d_][r] *= al_l[crow(r, hi)]; } } while (0)
    ATT_LOAD(64);
    SBAR(); ATT_QKT(pA0, pA1, 0, 0);
    ATT_MASK(pA0, pA1, 0); partialSM(pA0, pA1, m_reg, mnA, alA);
    ATT_WRITE(1);
    __syncthreads();
#define ATT_HALF_STEP(PX0, PX1, mnX, alX, PY0, PY1, alY, t, KB, VB, SB) do {                                                          \
        SBAR(); ATT_QKT(PX0, PX1, t, KB);                                                                                              \
        finishSM(PY0, PY1, alY, l_reg, pa0, pa1, pa2, pa3); SBAR();                                                                    \
        ATT_LOAD(((t) + 1) * 64); SBAR();                                                                                             \
        ATT_PV((t) - 1, VB); ATT_MASK(PX0, PX1, t); partialSM(PX0, PX1, m_reg, mnX, alX);                                              \
        __syncthreads();                                                                                                               \
        ATT_WRITE(SB);                                                                                                                 \
        ATT_RESC(alX); __syncthreads(); } while (0)
    for (int t = 1; t + 1 < T; t += 2) {
        ATT_HALF_STEP(pB0, pB1, mnB, alB, pA0, pA1, alA, t, 1, 0, 0);
        ATT_HALF_STEP(pA0, pA1, mnA, alA, pB0, pB1, alB, t + 1, 0, 1, 1);
    }
    SBAR(); ATT_QKT(pB0, pB1, T - 1, 1); SBAR();
    finishSM(pA0, pA1, alA, l_reg, pa0, pa1, pa2, pa3); SBAR();
    ATT_PV(T - 2, 0);
    ATT_MASK(pB0, pB1, T - 1); partialSM(pB0, pB1, m_reg, mnB, alB); ATT_RESC(alB);
    finishSM(pB0, pB1, alB, l_reg, pa0, pa1, pa2, pa3); SBAR(); ATT_PV(T - 1, 1);
#undef ATT_HALF_STEP
#undef ATT_RESC
#undef ATT_MASK
#undef ATT_PV
#undef ATT_QKT
#undef ATT_ACT
#undef ATT_LOAD
#undef ATT_WRITE
    __builtin_amdgcn_s_setprio(0);
    if (hi == 0) li_l[r32] = l_reg; asm volatile("s_waitcnt lgkmcnt(0)" ::: "memory");
    bf16* Ow = Og + (rowbase + (size_t)qb * MBLK + wid * 32) * PITCH + h * HD;
#pragma unroll
    for (int r = 0; r < 16; ++r) { const int orow = crow(r, hi); const float rl = __builtin_amdgcn_rcpf(li_l[orow]);
#pragma unroll
        for (int d0 = 0; d0 < 4; ++d0) { const float v = o[d0][r] * rl; const float vn = __shfl_xor(v, 1);
            if ((r32 & 1) == 0) *(unsigned*)(Ow + (size_t)orow * PITCH + d0 * 32 + r32) = cvtpk(v, vn); } }
}
#undef KSWZ
#undef SBAR
}
namespace hg {
using att::f32x16; using att::s16x4; using att::crow; using att::cvtpk;
constexpr int SET_BYTES = 49152, H_KD = 0, H_QD = 16384, H_IV = 32768, H_OB = 2 * SET_BYTES, OB_BYTES = 16384;
static_assert(H_OB + 2 * OB_BYTES <= RING_BYTES, "HGRN LDS map");
#define HG_KSWZ(row, colB) ((row) * 256 + ((colB) ^ (((row) & 7) << 4)))
typedef unsigned u32x2v __attribute__((ext_vector_type(2)));
typedef float f32x2v __attribute__((ext_vector_type(2)));
#define HG_TRRD(dst, base, off) asm volatile("ds_read_b64_tr_b16 %0, %1 offset:%2" : "=&v"(dst) : "v"(base), "i"(off) : "memory")
#define HG_MFMA(a, b, c) __builtin_amdgcn_mfma_f32_32x32x16_bf16(a, b, c, 0, 0, 0)
#define HG_BF8(l, h) ((bf16x8){l[0], l[1], l[2], l[3], h[0], h[1], h[2], h[3]})
#define HG_IBAR() do { asm volatile("s_waitcnt lgkmcnt(0)" ::: "memory"); __builtin_amdgcn_s_barrier(); asm volatile("" ::: "memory"); } while (0)

template <int TH>
__device__ __forceinline__ void m_half(const LAS char* KD, const LAS char* QD, LAS char* OBt, const f32x16 (&S)[4], bf16x8 B0, bf16x8 B1, bf16x8 B2, bf16x8 B3, int vt, int r32, int hi) {
    const int trow = TH * 32 + r32;
    bf16x8 qr[8];
#pragma unroll
    for (int d0 = 0; d0 < 8; ++d0) qr[d0] = *(const LAS bf16x8*)(QD + HG_KSWZ(trow, (d0 * 16 + hi * 8) * 2));
    f32x16 p0 = {}, p1 = {};
    { const LAS char* kb[4];
#pragma unroll
      for (int dd = 0; dd < 4; ++dd) kb[dd] = KD + HG_KSWZ(r32, (dd * 16 + hi * 8) * 2);
#pragma unroll
      for (int d0 = 0; d0 < 8; ++d0) { const LAS char* a = kb[d0 & 3] + (d0 >> 2) * 128;
          p0 = HG_MFMA(*reinterpret_cast<const LAS bf16x8*>(a), qr[d0], p0);
          if (TH == 1) p1 = HG_MFMA(*reinterpret_cast<const LAS bf16x8*>(a + 32 * 256), qr[d0], p1); } }
#pragma unroll
    for (int r = 0; r < 16; ++r) { const int s0 = crow(r, hi); p0[r] = (s0 <= trow) ? p0[r] : 0.f; if (TH == 1) p1[r] = (s0 + 32 <= trow) ? p1[r] : 0.f; }
    bf16x8 pa0, pa1, pa2, pa3; att::pack_p(p0, p1, pa0, pa1, pa2, pa3);
    f32x16 o = {};
    o = HG_MFMA(pa0, B0, o); o = HG_MFMA(pa1, B1, o);
    if (TH == 1) { o = HG_MFMA(pa2, B2, o); o = HG_MFMA(pa3, B3, o); }
#pragma unroll
    for (int dt = 0; dt < 4; ++dt)
#pragma unroll
        for (int s2 = 0; s2 < 2; ++s2) { const int cb = (dt * 32 + 16 * s2 + 4 * hi) * 2;
            const u32x2v a0 = *(const LAS u32x2v*)(QD + HG_KSWZ(trow, cb)), a1 = *(const LAS u32x2v*)(QD + HG_KSWZ(trow, cb + 16));
            v4u aw = {a0.x, a0.y, a1.x, a1.y}; v4u bw = {cvtpk(S[dt][8 * s2 + 0], S[dt][8 * s2 + 1]), cvtpk(S[dt][8 * s2 + 2], S[dt][8 * s2 + 3]), cvtpk(S[dt][8 * s2 + 4], S[dt][8 * s2 + 5]), cvtpk(S[dt][8 * s2 + 6], S[dt][8 * s2 + 7])};
            o = HG_MFMA(*reinterpret_cast<bf16x8*>(&aw), *reinterpret_cast<bf16x8*>(&bw), o); }
#pragma unroll
    for (int r = 0; r < 16; ++r) { const float v = o[r], vn = __shfl_xor(v, 1);
        if ((r32 & 1) == 0) *(LAS unsigned*)(OBt + (TH * 32 + crow(r, hi)) * 256 + (vt * 32 + r32) * 2) = cvtpk(v, vn); }
}
__device__ __forceinline__ void hgrn_unit(LAS char* lds, LAS float* CLb  , int b, int h, const float* Fg, const bf16* QBg, const bf16* IBg, const bf16* SGg, bf16* YB, const float* gain) {
    int tid_ = threadIdx.x; asm volatile("" : "+v"(tid_));
    const int tid = tid_, wid = __builtin_amdgcn_readfirstlane(tid >> 6), lane = tid & 63, r32 = lane & 31, hi = lane >> 5;
    const size_t rowbase = (size_t)b * SEQ; const int colh = h * HD;
    constexpr int NCH = SEQ / 64;
    __syncthreads();
    if (wid < 4) {
        __builtin_amdgcn_s_setprio(1);
        const int vt = wid;
        f32x16 S[4] = {};
        const int g = lane >> 4, q4 = (lane >> 2) & 3, p4 = lane & 3;
        const int kdT = (8 * hi + q4) * 256 + ((32 * (g & 1) + 8 * p4) ^ (16 * q4));
        const int vrd = att::v_rd_base(lane) + vt * 512;
        __syncthreads();
        for (int n = 0; n < NCH; ++n) {
            const LAS char* setp = lds + (n & 1) * SET_BYTES; const LAS char* KD = setp + H_KD; const LAS char* QD = setp + H_QD;
            LAS char* OBt = lds + H_OB + (n & 1) * OB_BYTES; const LAS float* CL = CLb + (n & 1) * 128;
            const int vb = (int)(uintptr_t)(setp + H_IV) + vrd;
            s16x4 l0, l1, l2, l3, h0, h1, h2, h3;
            HG_TRRD(l0, vb, 0); HG_TRRD(h0, vb, 2048); HG_TRRD(l1, vb, 4096); HG_TRRD(h1, vb, 6144); HG_TRRD(l2, vb, 8192); HG_TRRD(h2, vb, 10240); HG_TRRD(l3, vb, 12288); HG_TRRD(h3, vb, 14336);
            asm volatile("s_waitcnt lgkmcnt(0)" ::: "memory"); __builtin_amdgcn_sched_barrier(0);
            const bf16x8 B0 = HG_BF8(l0, h0), B1 = HG_BF8(l1, h1), B2 = HG_BF8(l2, h2), B3 = HG_BF8(l3, h3);
            m_half<0>(KD, QD, OBt, S, B0, B1, B2, B3, vt, r32, hi);
            m_half<1>(KD, QD, OBt, S, B0, B1, B2, B3, vt, r32, hi);
            const int kb = (int)(uintptr_t)KD + kdT;
#pragma unroll
            for (int dt = 0; dt < 4; ++dt) {
                s16x4 a0, a1, a2, a3, a4, a5, a6, a7;
#define HG_KOFF(ks, hf) ((ks) * 4096 + (hf) * 1024 + (((dt) * 64) ^ ((hf) * 64)))
                HG_TRRD(a0, kb, HG_KOFF(0, 0)); HG_TRRD(a1, kb, HG_KOFF(0, 1)); HG_TRRD(a2, kb, HG_KOFF(1, 0)); HG_TRRD(a3, kb, HG_KOFF(1, 1));
                HG_TRRD(a4, kb, HG_KOFF(2, 0)); HG_TRRD(a5, kb, HG_KOFF(2, 1)); HG_TRRD(a6, kb, HG_KOFF(3, 0)); HG_TRRD(a7, kb, HG_KOFF(3, 1));
#undef HG_KOFF
                asm volatile("s_waitcnt lgkmcnt(0)" ::: "memory"); __builtin_amdgcn_sched_barrier(0);
                S[dt] = HG_MFMA(HG_BF8(a0, a1), B0, S[dt]); S[dt] = HG_MFMA(HG_BF8(a2, a3), B1, S[dt]); S[dt] = HG_MFMA(HG_BF8(a4, a5), B2, S[dt]); S[dt] = HG_MFMA(HG_BF8(a6, a7), B3, S[dt]);
#pragma unroll
                for (int gg = 0; gg < 4; ++gg) { const f32x4 c4 = *(const LAS f32x4*)(CL + dt * 32 + 8 * gg + 4 * hi);
#pragma unroll
                    for (int j = 0; j < 4; ++j) S[dt][4 * gg + j] *= c4[j]; }
            }
            HG_IBAR();
        }
        HG_IBAR();
        __builtin_amdgcn_s_setprio(0);
    } else {
        const int ew = wid - 4, te = tid - 256;
        const int g8 = lane >> 3, cq = lane & 7, dch = 32 * ew + 4 * cq;
        const int isr = te >> 4, isc = (te & 15) * 8;
        const int nrow = te >> 2, npart = te & 3;
        f32x4 fraw[8]; u32x2v qraw[8]; bf16x8 iraw[4]; v4u sgraw[4];
#define HG_LOAD(n) do { _Pragma("unroll") for (int tt = 0; tt < 8; ++tt) { const size_t gi = (rowbase + (n) * 64 + 8 * g8 + tt) * AW + colh + dch; fraw[tt] = __builtin_nontemporal_load((const f32x4*)(Fg + gi)); qraw[tt] = __builtin_nontemporal_load((const u32x2v*)(QBg + gi)); } \
        _Pragma("unroll") for (int k = 0; k < 4; ++k) iraw[k] = __builtin_nontemporal_load((const bf16x8*)(IBg + (rowbase + (n) * 64 + isr + 16 * k) * AW + colh + isc)); } while (0)
#define HG_LOADSG(n) do { _Pragma("unroll") for (int k = 0; k < 4; ++k) sgraw[k] = __builtin_nontemporal_load((const v4u*)(SGg + (rowbase + (n) * 64 + nrow) * AW + colh + 32 * npart + 8 * k)); } while (0)
#define HG_ESTAGE(n) do { LAS char* setp = lds + ((n) & 1) * SET_BYTES; LAS char* KD = setp + H_KD; LAS char* QD = setp + H_QD; LAS char* IV = setp + H_IV;                         \
            float lc[8][4], inc[4], exc[4], cl[4];                                                                                                                                  \
            _Pragma("unroll") for (int k = 0; k < 4; ++k) { float c = 1.f; _Pragma("unroll") for (int tt = 0; tt < 8; ++tt) { c *= fraw[tt][k]; lc[tt][k] = c; } inc[k] = c; }       \
            _Pragma("unroll") for (int off = 8; off < 64; off <<= 1) _Pragma("unroll") for (int k = 0; k < 4; ++k) { const float v = __shfl_up(inc[k], off); inc[k] = (lane >= off) ? inc[k] * v : inc[k]; } \
            _Pragma("unroll") for (int k = 0; k < 4; ++k) { const float e = __shfl_up(inc[k], 8); exc[k] = (g8 == 0) ? 1.f : e; cl[k] = __shfl(inc[k], 56 + cq); }                   \
            _Pragma("unroll") for (int tt = 0; tt < 8; ++tt) { float qd[4], kd[4];                                                                                                  \
                const float qq[4] = {__uint_as_float(qraw[tt].x << 16), __uint_as_float(qraw[tt].x & 0xffff0000u), __uint_as_float(qraw[tt].y << 16), __uint_as_float(qraw[tt].y & 0xffff0000u)}; \
                _Pragma("unroll") for (int k = 0; k < 4; ++k) { const float cp = exc[k] * lc[tt][k]; qd[k] = qq[k] * cp; kd[k] = (1.0f - fraw[tt][k]) * __builtin_amdgcn_rcpf(cp); }   \
                const int t = 8 * g8 + tt, a = HG_KSWZ(t, dch * 2);                                                                                                                 \
                u32x2v wq, wk; wq.x = cvtpk(qd[0], qd[1]); wq.y = cvtpk(qd[2], qd[3]); wk.x = cvtpk(kd[0], kd[1]); wk.y = cvtpk(kd[2], kd[3]);                                       \
                *(LAS u32x2v*)(QD + a) = wq; *(LAS u32x2v*)(KD + a) = wk; }                                                                                                         \
            if (g8 == 0) *(LAS f32x4*)(CLb + ((n) & 1) * 128 + dch) = (f32x4){cl[0], cl[1], cl[2], cl[3]};                                                                          \
            _Pragma("unroll") for (int k = 0; k < 4; ++k) *(LAS bf16x8*)(IV + att::v_st(isr + 16 * k, isc)) = iraw[k]; } while (0)
        HG_LOAD(0); HG_ESTAGE(0); HG_LOAD(1); HG_LOADSG(0);
        __syncthreads();
        for (int n = 0; n <= NCH; ++n) {
            if (n >= 1) { const int m = n - 1; const LAS char* OBt = lds + H_OB + (m & 1) * OB_BYTES + nrow * 256 + npart * 64;
                float ov[32]; float ss = 0.f;
#pragma unroll
                for (int k = 0; k < 4; ++k) { const v4u w = *(const LAS v4u*)(OBt + 16 * k);
                    ov[8 * k + 0] = __uint_as_float(w.x << 16); ov[8 * k + 1] = __uint_as_float(w.x & 0xffff0000u); ov[8 * k + 2] = __uint_as_float(w.y << 16); ov[8 * k + 3] = __uint_as_float(w.y & 0xffff0000u);
                    ov[8 * k + 4] = __uint_as_float(w.z << 16); ov[8 * k + 5] = __uint_as_float(w.z & 0xffff0000u); ov[8 * k + 6] = __uint_as_float(w.w << 16); ov[8 * k + 7] = __uint_as_float(w.w & 0xffff0000u); }
#pragma unroll
                for (int j = 0; j < 32; ++j) ss = fmaf(ov[j], ov[j], ss);
                ss += __shfl_xor(ss, 1); ss += __shfl_xor(ss, 2);
                const float rstd = 1.0f / sqrtf(ss * (1.0f / HD) + NORM_EPS);
                bf16* yp = YB + (rowbase + m * 64 + nrow) * AW + colh + 32 * npart; const float* gp = gain + colh + 32 * npart;
#pragma unroll
                for (int k = 0; k < 4; ++k) { const f32x4 g0 = *(const f32x4*)(gp + 8 * k), g1 = *(const f32x4*)(gp + 8 * k + 4); const v4u sw = sgraw[k];
                    v4u yw;
                    yw.x = cvtpk(ov[8 * k + 0] * rstd * g0[0] * __uint_as_float(sw.x << 16), ov[8 * k + 1] * rstd * g0[1] * __uint_as_float(sw.x & 0xffff0000u));
                    yw.y = cvtpk(ov[8 * k + 2] * rstd * g0[2] * __uint_as_float(sw.y << 16), ov[8 * k + 3] * rstd * g0[3] * __uint_as_float(sw.y & 0xffff0000u));
                    yw.z = cvtpk(ov[8 * k + 4] * rstd * g1[0] * __uint_as_float(sw.z << 16), ov[8 * k + 5] * rstd * g1[1] * __uint_as_float(sw.z & 0xffff0000u));
                    yw.w = cvtpk(ov[8 * k + 6] * rstd * g1[2] * __uint_as_float(sw.w << 16), ov[8 * k + 7] * rstd * g1[3] * __uint_as_float(sw.w & 0xffff0000u));
                    *(v4u*)(yp + 8 * k) = yw; } }
            if (n < NCH) HG_LOADSG(n);
            if (n + 1 < NCH) { HG_ESTAGE(n + 1); if (n + 2 < NCH) HG_LOAD(n + 2); }
            HG_IBAR();
        }
#undef HG_ESTAGE
#undef HG_LOADSG
#undef HG_LOAD
    }
}
#undef HG_IBAR
#undef HG_BF8
#undef HG_MFMA
#undef HG_TRRD
#undef HG_KSWZ
}
#define PH_IDS() int tid_ = threadIdx.x; asm volatile("" : "+v"(tid_)); const int tid = tid_, lane = tid & 63, wave = __builtin_amdgcn_readfirstlane(tid >> 6); (void)lane; (void)wave
struct Frame {
    LAS unsigned char* lds;
    volatile LAS unsigned* MISC;
    gu32* ctl;
    int vcu, G;
    unsigned char* ws;
    const float* in[16];
    float* out;
};
__device__ const unsigned char k_t5b[128] = {0, 1, 2, 3, 4, 5, 6, 7, 8, 9, 10, 11, 12, 13, 14, 15, 16, 16, 16, 17, 17, 18, 18, 18, 19, 19, 19, 20, 20, 20, 20, 21, 21, 21, 21, 22, 22, 22, 22, 22, 23, 23, 23, 23, 23, 23,
    24, 24, 24, 24, 24, 24, 25, 25, 25, 25, 25, 25, 25, 26, 26, 26, 26, 26, 26, 26, 26, 27, 27, 27, 27, 27, 27, 27, 27, 27, 27, 28, 28, 28, 28, 28, 28, 28, 28, 28, 28, 29, 29, 29, 29, 29, 29, 29, 29, 29, 29, 29, 29,
    30, 30, 30, 30, 30, 30, 30, 30, 30, 30, 30, 30, 30, 30, 31, 31, 31, 31, 31, 31, 31, 31, 31, 31, 31, 31, 31, 31, 31};

__device__ __forceinline__ void p0_transpose_item(const float* W, int K, int N, bf16* WT, const float* gain, int mapmode, LAS float* scr, int item, int lane) {
    const int nblk = N / 32, kb = item / nblk, nb = item % nblk, k0 = 64 * kb, n0 = 32 * nb;
    const int kr = lane >> 3, nq = 4 * (lane & 7);
    f32x4 v[8];
#pragma unroll
    for (int i = 0; i < 8; ++i) v[i] = __builtin_nontemporal_load((const GAS f32x4*)(W + (size_t)(k0 + 8 * i + kr) * N + n0 + nq));
    if (gain) {
#pragma unroll
        for (int i = 0; i < 8; ++i) v[i] = v[i] * gain[k0 + 8 * i + kr]; }
#pragma unroll
    for (int i = 0; i < 8; ++i) { LAS float* s = scr + (8 * i + kr) * 33 + nq; s[0] = v[i].x; s[1] = v[i].y; s[2] = v[i].z; s[3] = v[i].w; }
    LDS_WAIT(); asm volatile("" ::: "memory");
    int r0 = n0;
    if (mapmode == 1) { const int j = n0 < DFF ? n0 : n0 - DFF; r0 = 256 * (j >> 7) + (j & 127) + (n0 < DFF ? 0 : 128); }
    const int c = lane & 7;
#pragma unroll
    for (int j = 0; j < 4; ++j) { const int n = (lane >> 3) + 8 * j; const LAS float* s = scr + (8 * c) * 33 + n;
        v4u o; o.x = pk2(s[0 * 33], s[1 * 33]); o.y = pk2(s[2 * 33], s[3 * 33]); o.z = pk2(s[4 * 33], s[5 * 33]); o.w = pk2(s[6 * 33], s[7 * 33]);
        *(GAS v4u*)(WT + (size_t)(r0 + n) * K + k0 + 8 * c) = o; }
    LDS_WAIT(); asm volatile("" ::: "memory");
}
constexpr int I_IN = (DM / 64) * (INW / 32), I_GU = (DM / 64) * (2 * DFF / 32), I_DN = (DFF / 64) * (DM / 32), I_SQ = (DM / 64) * (DM / 32), I_AB = (AW / 64) * (DM / 32), I_PLE = (PLED / 64) * (DM / 32);
constexpr int I_LATE = I_GU + I_DN + 2 * I_SQ + 2 * I_AB + I_PLE;
__device__ __forceinline__ void p0_late_item(Frame& F, LAS float* scr, int r, int lane) {
    bf16* Wgu_t = (bf16*)(F.ws + WS_WGU); bf16* Wdn_t = (bf16*)(F.ws + WS_WDN); bf16* Wout_t = (bf16*)(F.ws + WS_WOUT);
    bf16* Wpg_t = (bf16*)(F.ws + WS_WPG); bf16* Wa_t = (bf16*)(F.ws + WS_WA); bf16* Wb_t = (bf16*)(F.ws + WS_WB); bf16* Wple_t = (bf16*)(F.ws + WS_WPLE);
    if (r < I_GU) { p0_transpose_item(F.in[9], DM, 2 * DFF, Wgu_t, F.in[8], 1, scr, r, lane); return; } r -= I_GU;
    if (r < I_DN) { p0_transpose_item(F.in[10], DFF, DM, Wdn_t, nullptr, 0, scr, r, lane); return; } r -= I_DN;
    if (r < I_SQ) { p0_transpose_item(F.in[7], DM, DM, Wout_t, nullptr, 0, scr, r, lane); return; } r -= I_SQ;
    if (r < I_SQ) { p0_transpose_item(F.in[12], DM, DM, Wpg_t, nullptr, 0, scr, r, lane); return; } r -= I_SQ;
    if (r < I_AB) { p0_transpose_item(F.in[5], AW, DM, Wa_t, nullptr, 0, scr, r, lane); return; } r -= I_AB;
    if (r < I_AB) { p0_transpose_item(F.in[6], AW, DM, Wb_t, nullptr, 0, scr, r, lane); return; } r -= I_AB;
    p0_transpose_item(F.in[11], PLED, DM, Wple_t, nullptr, 0, scr, r, lane);
}
__device__ __forceinline__ void p0_filler(Frame& F, int part) {
    PH_IDS();
    LAS float* scr = (LAS float*)(F.lds + RING_OFF + wave * 16384);
    const int gw = F.vcu * NWAVES + wave, NGW = F.G * NWAVES;
    const int nw = (I_LATE - gw + NGW - 1) / NGW, cut = (nw * (int)(blockIdx.x & 7) + 3) / 7;
    const int j0 = part == 0 ? 0 : cut, j1 = part == 0 ? cut : nw;
#pragma nounroll
    for (int j = j0; j < j1; ++j) p0_late_item(F, scr, gw + j * NGW, lane);
}
__device__ __forceinline__ void p0_prologue(Frame& F) {
    PH_IDS();
    LAS float* scr = (LAS float*)(F.lds + RING_OFF + wave * 16384);
    const int gw = F.vcu * NWAVES + wave, NGW = F.G * NWAVES;
    bf16* Win_t = (bf16*)(F.ws + WS_WIN);
#define P0_TRANSPOSES() do { \
    for (int it = gw; it < I_IN; it += NGW) p0_transpose_item(F.in[3], DM, INW, Win_t, F.in[2], 0, scr, it, lane); \
    } while (0)
    const bool xfirst = (wave & 1) != 0;
    if (!xfirst) P0_TRANSPOSES();
    { bf16* XB = (bf16*)(F.ws + WS_RA); float* rstd0 = (float*)(F.ws + WS_RSTD0); const float* x = F.in[0];
      for (int m = gw; m < M; m += NGW) { const GAS f32x4* xr = (const GAS f32x4*)(x + (size_t)m * DM) + lane; f32x4 v[8]; float s = 0.f;
#pragma unroll
          for (int j = 0; j < 8; ++j) { v[j] = __builtin_nontemporal_load(xr + 64 * j); s += (v[j].x * v[j].x + v[j].y * v[j].y) + (v[j].z * v[j].z + v[j].w * v[j].w); }
          s = wave_sum(s); if (lane == 0) rstd0[m] = 1.0f / sqrtf(s * (1.0f / DM) + NORM_EPS);
          GAS unsigned long long* o8 = (GAS unsigned long long*)(XB + (size_t)m * DM) + lane;
#pragma unroll
          for (int j = 0; j < 8; ++j) o8[64 * j] = (unsigned long long)pk2(v[j].x, v[j].y) | ((unsigned long long)pk2(v[j].z, v[j].w) << 32); } }
    { bf16* PB = (bf16*)(F.ws + WS_PB); const GAS f32x4* p4 = (const GAS f32x4*)F.in[1]; GAS unsigned long long* o8 = (GAS unsigned long long*)PB;
      const int gt = gw * 64 + lane, NGT = NGW * 64;
      for (int i = gt; i < M * PLED / 4; i += NGT) { const f32x4 v = __builtin_nontemporal_load(p4 + i); o8[i] = (unsigned long long)pk2(v.x, v.y) | ((unsigned long long)pk2(v.z, v.w) << 32); } }
    if (xfirst) P0_TRANSPOSES();
#undef P0_TRANSPOSES
    if (blockIdx.x == 0) { float* lb = (float*)(F.ws + WS_LB); const float* lg = F.in[14];
        for (int d = tid; d < AW; d += NWAVES * 64) lb[d] = 1.0f / (1.0f + expf(lg[AW + d] - lg[d])); }
    if (blockIdx.x == 1 || F.G == 1) { float* tb = (float*)(F.ws + WS_TB); const float* rb = F.in[13];
        for (int i = tid; i < NH * 129; i += NWAVES * 64) { const int h = i / 129, rel = i % 129; tb[i] = rel < 128 ? (rb[(int)k_t5b[rel] * NH + h] - rb[31 * NH + h]) * (1.0f / att::SCALE) : 0.f; } }
}
__device__ __forceinline__ void p9_final(Frame& F, const bf16* X3B) {
    PH_IDS();
    const float* ssp = (const float*)(F.ws + WS_SS3); const float* gain = F.in[15];
    f32x4 gv[8];
#pragma unroll
    for (int j = 0; j < 8; ++j) gv[j] = *((const GAS f32x4*)gain + lane + 64 * j);
    const int prow0 = (8 * (int)(blockIdx.x & 7) + (int)((blockIdx.x >> 3) & 7)) * 256 + (int)(blockIdx.x >> 6) * 64;
    for (int m = prow0 + wave; m < prow0 + 64; m += NWAVES) {
        float s = lane < 32 ? ssp[(size_t)m * 32 + lane] : 0.f; s = wave_sum(s);
        const float rstd = 1.0f / sqrtf(s * (1.0f / DM) + NORM_EPS);
        const GAS unsigned long long* xi = (const GAS unsigned long long*)(X3B + (size_t)m * DM) + lane; GAS f32x4* xr = (GAS f32x4*)(F.out + (size_t)m * DM) + lane;
        unsigned long long w[8];
#pragma unroll
        for (int j = 0; j < 8; ++j) w[j] = __builtin_nontemporal_load(xi + 64 * j);
#pragma unroll
        for (int j = 0; j < 8; ++j) { const unsigned lo = (unsigned)w[j], hi = (unsigned)(w[j] >> 32);
            f32x4 v = {__uint_as_float(lo << 16), __uint_as_float(lo & 0xffff0000u), __uint_as_float(hi << 16), __uint_as_float(hi & 0xffff0000u)};
            xr[64 * j] = v * rstd * gv[j]; }
    }
}
__device__ __forceinline__ void build_rstd_tab(Frame& F, const float* ssp, int pm) {
    PH_IDS();
    LAS float* tab = (LAS float*)(F.lds + TAB_OFF);
    const int row = tid >> 1, hf = tid & 1; const GAS f32x4* p = (const GAS f32x4*)(ssp + (size_t)(pm * 256 + row) * 32 + hf * 16);
    const f32x4 a = p[0], b = p[1], c = p[2], d = p[3];
    float s = ((a.x + a.y) + (a.z + a.w)) + ((b.x + b.y) + (b.z + b.w)) + ((c.x + c.y) + (c.z + c.w)) + ((d.x + d.y) + (d.z + d.w));
    const float o = __shfl_xor(s, 1); s = hf ? o + s : s + o;
    if (hf == 0) tab[row] = 1.0f / sqrtf(s * (1.0f / DM) + NORM_EPS);
    __syncthreads();
}

__device__ __forceinline__ void build_rstd0_tab(Frame& F, const float* rstd0, int pm) {
    PH_IDS();
    LAS float* tab = (LAS float*)(F.lds + TAB_OFF);
    if (tid < 256) tab[tid] = rstd0[pm * 256 + tid];
    __syncthreads();
}
struct Args { const float* in[16]; float* out; unsigned char* ws; int ph_lo, ph_hi; };
__global__ void __launch_bounds__(NWAVES * 64, 2) mk_fwd(Args args) {
    extern __shared__ __attribute__((aligned(16))) unsigned char lds[];
    Frame F;
    F.lds = (LAS unsigned char*)lds;
    F.MISC = (volatile LAS unsigned*)(F.lds + MISC_OFF);
    F.G = gridDim.x; { const int bx = blockIdx.x; F.vcu = (F.G % 8 == 0) ? (bx % 8) * (F.G / 8) + bx / 8 : bx; }
    F.ws = args.ws; F.ctl = (gu32*)(args.ws + WS_CTL); F.out = args.out;
#pragma unroll
    for (int i = 0; i < 16; ++i) F.in[i] = args.in[i];
    for (int u = threadIdx.x; u < (LDS_BYTES - LDSCTL_OFF) / 4; u += NWAVES * 64) ((LAS unsigned*)(F.lds + LDSCTL_OFF))[u] = 0u;
    __syncthreads();
    XcdBarrier bar; bar.bar = (unsigned*)(F.ctl + CW_BAR); bar.x = 0; bar.st = nullptr;
    if (N_LAUNCHES == 1) bar = xcd_barrier_post((unsigned*)(F.ctl + CW_BAR), F.MISC + 8);
#define GRID_BAR() do { if (N_LAUNCHES == 1) xcd_barrier(bar); } while (0)
    GrpBar gbar; gbar.cnt = (unsigned*)(F.ctl + CW_GRP + 64 * (blockIdx.x & 7)); gbar.tgt = 0u; gbar.n = gridDim.x / 8; gbar.light = 0;
    if (N_LAUNCHES == 1 && threadIdx.x == 0) (void)__hip_atomic_fetch_or((unsigned*)(F.ctl + CW_GRPX + 64 * (blockIdx.x & 7)), 1u << bar.x, RLX_AGENT);
#define GRP_BAR() do { if (N_LAUNCHES == 1) grp_barrier(gbar, (unsigned*)(F.ctl + CW_BAR), nullptr); } while (0)
    GrpBar pbar; pbar.cnt = (unsigned*)(F.ctl + CW_PNL + 16 * (blockIdx.x & 63)); pbar.tgt = 0u; pbar.n = gridDim.x / 64; pbar.light = 0;
#define PNL_BAR() do { if (N_LAUNCHES == 1) grp_barrier(pbar, (unsigned*)(F.ctl + CW_BAR), nullptr); } while (0)
    const int lo = args.ph_lo, hi = args.ph_hi;
#ifndef PH_MASK
#define PH_MASK 0x3ff
#endif
#define IN(k) (((PH_MASK >> (k)) & 1) && lo <= (k) && (k) < hi)
#ifndef DUP_MASK
#define DUP_MASK 0
#endif
#define REP(k) for (int rep_ = 0; rep_ < 1 + ((DUP_MASK >> (k)) & 1); ++rep_)
    unsigned char* ws = args.ws;
    const int c = (int)blockIdx.x, bq = c & 7;
#define ARENA_PTR(off, rowbytes) (ws + WS_ARENA + (size_t)bq * (ARENA_STRIDE - (size_t)SEQ * (rowbytes)) + (off))
    bf16* XS = (bf16*)(ws + WS_RA); bf16* MIX = (bf16*)ARENA_PTR(AO_MIX, DM * 2); bf16* X3B = (bf16*)ARENA_PTR(AO_X3B, DM * 2);
    bf16* Qb = (bf16*)ARENA_PTR(AO_Q, AW * 2); bf16* Kb = (bf16*)ARENA_PTR(AO_K, AW * 2); bf16* Vb = (bf16*)ARENA_PTR(AO_V, AW * 2); bf16* QBb = (bf16*)ARENA_PTR(AO_QB, AW * 2); float* Fb = (float*)ARENA_PTR(AO_F, AW * 4);
    bf16* IBb = (bf16*)ARENA_PTR(AO_IB, AW * 2); bf16* SGb = (bf16*)ARENA_PTR(AO_SG, AW * 2); bf16* YB = (bf16*)ARENA_PTR(AO_YB, AW * 2); bf16* YA = (bf16*)ARENA_PTR(AO_YA, AW * 2);
    bf16* GA = (bf16*)((unsigned char*)args.out + (size_t)bq * (8 * MiB)); bf16* GB = (bf16*)((unsigned char*)GA + 8 * MiB);
    bf16* ACT = (bf16*)ARENA_PTR(AO_ACT, DFF * 2); bf16* PLEb = (bf16*)ARENA_PTR(AO_PLE, DM * 2); bf16* PB = (bf16*)(ws + WS_PB);
#undef ARENA_PTR

    if (IN(0)) { p0_prologue(F); GRID_BAR();
        if (N_LAUNCHES == 1) { const unsigned xm = xb_ld((unsigned*)(F.ctl + CW_GRPX + 64 * (blockIdx.x & 7))); gbar.light = __builtin_amdgcn_readfirstlane((xm & (xm - 1u)) == 0u ? 1 : 0); pbar.light = gbar.light; }
#if defined(PROBE_P0)
        p0_prologue(F); GRID_BAR();
#endif
    }
    if (IN(1)) REP(1) {
        p0_filler(F, 0); __syncthreads();
        pg8::Gemm g{XS, (const bf16*)(ws + WS_WIN), M, INW, DM}; pg8::StaticOrder S; S.init(M, INW, F.G, c);
        pg8::Unit u0; S.next(0, u0); build_rstd0_tab(F, (const float*)(ws + WS_RSTD0), u0.pm);
        pg8::EpiInProj E{Qb, Kb, Vb, QBb, IBb, SGb, GA, GB, Fb, (const PG8_LAS float*)(F.lds + TAB_OFF), (const float*)(ws + WS_LB), (float*)(ws + WS_KMEAN)};
        pg8::gemm_phase<pg8::EpiInProj, pg8::StaticOrder, PG8_ALIGN, PG8_SP2>(F.lds + RING_OFF, g, S, E);
        __syncthreads(); p0_filler(F, 1);
        if (N_LAUNCHES == 1) grp_barrier(gbar, (unsigned*)(F.ctl + CW_BAR), (unsigned*)(F.ctl + CW_LATE));
#if defined(PROBE_KLOOP)
        { pg8::EpiNull E0;
#if PROBE_KLOOP == 2
          pg8::SameTileOrder S0; S0.n = 11; pg8::gemm_phase<pg8::EpiNull, pg8::SameTileOrder, PG8_ALIGN, PG8_SP2>(F.lds + RING_OFF, g, S0, E0);
#else
          pg8::gemm_phase<pg8::EpiNull, pg8::StaticOrder, PG8_ALIGN, PG8_SP2>(F.lds + RING_OFF, g, S, E0);
#endif
          GRID_BAR(); }
#endif
    }
    {
        const float* kmp = (const float*)(ws + WS_KMEAN); const float* tb = (const float*)(ws + WS_TB);
#define P2_BODY(do_h, do_a) do {                                                                                                                                                  \
        if (F.G == 256) {                                                                                                                                                       \
            const int xg = F.vcu >> 5, xi = F.vcu & 31;                                                                                                                         \
            if (xi < 8) { const int it = xg * 8 + xi; if (do_h) hg::hgrn_unit((LAS char*)(F.lds + RING_OFF), (LAS float*)(F.lds + TAB_OFF), it / NH, it % NH, Fb, QBb, IBb, SGb, YB, F.in[4]); } \
            else { const int a = xg * 24 + (xi - 8), bh = a / 3, grp = a - 3 * bh, b = bh / NH, h = bh % NH;                                                                    \
                const int list = grp == 0 ? 0x37 : (grp == 1 ? 0x126 : 0x045), cnt = grp == 0 ? 2 : 3;       \
                if (do_a) { _Pragma("nounroll") for (int i = 0; i < cnt; ++i) att::attn_unit((LAS char*)(F.lds + RING_OFF), b, h, (list >> (4 * i)) & 15, Qb, Kb, Vb, YA, kmp, tb + h * 129); } } \
        } else {                                                                                                                                                                \
            for (int it = F.vcu; it < BATCH * NH; it += F.G) hg::hgrn_unit((LAS char*)(F.lds + RING_OFF), (LAS float*)(F.lds + TAB_OFF), it / NH, it % NH, Fb, QBb, IBb, SGb, YB, F.in[4]);  \
            for (int v = F.vcu; v < BATCH * NH * NBLK; v += F.G) { const int bh = v >> 3; att::attn_unit((LAS char*)(F.lds + RING_OFF), bh / NH, bh % NH, 7 - (v & 7), Qb, Kb, Vb, YA, kmp, tb + (bh % NH) * 129); } \
        }                                                                                                                                                                       \
        GRP_BAR(); } while (0)
        if (IN(2)) { P2_BODY(true, true);
#if defined(PROBE_P2)
            P2_BODY((PROBE_P2 & 2) != 0, (PROBE_P2 & 1) != 0);
#endif
        }
#undef P2_BODY
    }
#if defined(PROBE_XBAR)
    GRID_BAR();
#endif
    if (IN(4)) REP(4) {
        if (N_LAUNCHES == 1) late_wait((unsigned*)(F.ctl + CW_LATE), gridDim.x, (unsigned*)(F.ctl + CW_BAR));
        pg8::Gemm g{YA, (const bf16*)(ws + WS_WA), M, DM, AW, YB, (const bf16*)(ws + WS_WB)}; pg8::StaticOrder S; S.init(M, DM, F.G, c); pg8::EpiMix2 E{MIX, GA, GB};
        pg8::gemm_phase<pg8::EpiMix2, pg8::StaticOrder, PG8_ALIGN, PG8_SP2, true>(F.lds + RING_OFF, g, S, E);
        GRP_BAR();
    }
    if (IN(5)) REP(5) {
        pg8::Gemm g{MIX, (const bf16*)(ws + WS_WOUT), M, DM, DM}; pg8::StaticOrder S; S.init(M, DM, F.G, c);
        pg8::EpiResid<true> E{XS, XS, (float*)(ws + WS_SS1)};
        pg8::gemm_phase<pg8::EpiResid<true>, pg8::StaticOrder, PG8_ALIGN, PG8_SP2>(F.lds + RING_OFF, g, S, E);
        PNL_BAR();
    }
    if (IN(6)) REP(6) {
        pg8::Gemm g{XS, (const bf16*)(ws + WS_WGU), M, 2 * DFF, DM}; pg8::StaticOrder S; S.init(M, 2 * DFF, F.G, c);
        pg8::Unit u0; S.next(0, u0); build_rstd_tab(F, (const float*)(ws + WS_SS1), u0.pm);
        pg8::EpiGateUp E{ACT, (const PG8_LAS float*)(F.lds + TAB_OFF), DFF};
        pg8::gemm_phase<pg8::EpiGateUp, pg8::StaticOrder, PG8_ALIGN, PG8_SP2>(F.lds + RING_OFF, g, S, E);
        PNL_BAR();
    }
    if (IN(7)) {
        pg8::Gemm g{ACT, (const bf16*)(ws + WS_WDN), M, DM, DFF}; pg8::StaticOrder S; S.init(M, DM, F.G, c);
        pg8::EpiResid<false> E{XS, XS, nullptr};
        pg8::gemm_phase<pg8::EpiResid<false>, pg8::StaticOrder, PG8_ALIGN, PG8_SP2>(F.lds + RING_OFF, g, S, E);
        GRP_BAR();
    }
    if (IN(8)) {
        { pg8::Gemm g{PB, (const bf16*)(ws + WS_WPLE), M, DM, PLED}; pg8::StaticOrder S; S.init(M, DM, F.G, c); pg8::EpiPle E{PLEb};
          pg8::gemm_phase<pg8::EpiPle, pg8::StaticOrder, PG8_ALIGN, PG8_SP2>(F.lds + RING_OFF, g, S, E); }
        VM_WAIT(); __syncthreads();
        { pg8::Gemm g{XS, (const bf16*)(ws + WS_WPG), M, DM, DM}; pg8::StaticOrder S; S.init(M, DM, F.G, c); pg8::EpiPleGate E{XS, X3B, PLEb, (float*)(ws + WS_SS3)};
          pg8::gemm_phase<pg8::EpiPleGate, pg8::StaticOrder, PG8_ALIGN, PG8_SP2>(F.lds + RING_OFF, g, S, E); }
        PNL_BAR();
    }
    if (IN(9)) { p9_final(F, X3B); }
#undef IN
#undef GRID_BAR
#undef GRP_BAR
#undef PNL_BAR
}

extern "C" void kernel_launch(void* const* d_in, const int* in_sizes, int n_in, void* d_out, int out_size, void* d_ws, size_t ws_size, hipStream_t stream) {
    static int grid = 0;
    if (grid == 0) {
        if (n_in != 16 || in_sizes[0] != M * DM || out_size != M * DM || ws_size < WS_END) { fprintf(stderr, "kernel_launch: shape/workspace mismatch (n_in %d, in0 %d, out %d, ws %zu, need %zu); nothing launched\n", n_in, n_in > 0 ? in_sizes[0] : -1, out_size, ws_size, (size_t)WS_END); grid = -1; return; }
        int dev = 0, cus = 0, per_cu = 0;
        if (hipGetDevice(&dev) != hipSuccess || hipDeviceGetAttribute(&cus, hipDeviceAttributeMultiprocessorCount, dev) != hipSuccess) { fprintf(stderr, "kernel_launch: device query failed\n"); grid = -1; return; }
        if (hipFuncSetAttribute((const void*)mk_fwd, hipFuncAttributeMaxDynamicSharedMemorySize, LDS_BYTES) != hipSuccess) { fprintf(stderr, "kernel_launch: hipFuncSetAttribute failed\n"); grid = -1; return; }
        if (hipOccupancyMaxActiveBlocksPerMultiprocessor(&per_cu, (const void*)mk_fwd, NWAVES * 64, LDS_BYTES) != hipSuccess || per_cu < 1) { fprintf(stderr, "kernel_launch: occupancy query reports %d workgroups per CU\n", per_cu); }
        (void)hipGetLastError();
        if (cus != 256) { fprintf(stderr, "kernel_launch: %d CUs; this kernel's batch-group layout needs 256\n", cus); grid = -1; return; }
        grid = cus;
    }
    if (grid < 0) return;
    if (hipMemsetAsync((char*)d_ws + WS_CTL, 0, CTL_ZERO_BYTES, stream) != hipSuccess) { fprintf(stderr, "kernel_launch: memset failed\n"); return; }
    Args a{};
    for (int i = 0; i < 16; ++i) a.in[i] = (const float*)d_in[i];
    a.out = (float*)d_out; a.ws = (unsigned char*)d_ws;
    for (int li = 0; li < N_LAUNCHES; ++li) {
        a.ph_lo = (N_LAUNCHES == 1) ? 0 : li; a.ph_hi = (N_LAUNCHES == 1) ? N_PHASES : li + 1;
        hipLaunchKernelGGL(mk_fwd, dim3(grid), dim3(NWAVES * 64), LDS_BYTES, stream, a);
        const hipError_t le = hipPeekAtLastError();
        if (le != hipSuccess) { fprintf(stderr, "kernel_launch: launch %d failed: %s\n", li, hipGetErrorName(le)); break; }
    }
}
```

```cpp
#include <hip/hip_runtime.h>
#include <cstdio>
#include <cstdint>
namespace pg8 {
#define PG8_LAS __attribute__((address_space(3)))
typedef unsigned short bf16_t;
typedef short bf16x8 __attribute__((ext_vector_type(8)));
typedef float f32x4 __attribute__((ext_vector_type(4)));
typedef unsigned u32x4 __attribute__((ext_vector_type(4)));
constexpr int BM = 256, BK = 64, HALF = 128, HTB = HALF * BK * 2  , STAGE_BYTES = 8 * HTB, NXCD = 8, WGM = 8;

__host__ __device__ __forceinline__ int lds_byte(int r, int c) { const int st = (r >> 4) * 2 + (c >> 5), rr = r & 15, cc = c & 31, ob = rr * 64 + cc * 2; return st * 1024 + (ob ^ (((ob >> 9) & 1) << 5)); }
__host__ __device__ __forceinline__ void stage_rc(int b, int& R, int& C) { const int st = b / 1024, sb = b % 1024, swz = sb ^ (((sb >> 9) & 1) << 5); R = (st >> 1) * 16 + swz / 64; C = (st & 1) * 32 + (swz % 64) / 2; }
__host__ __device__ __forceinline__ int perm32(int rho) { const int n = rho >> 4, i = rho & 15; return 8 * (i >> 2) + 4 * n + (i & 3); }

struct Unit { int pm, pn; };
struct Gemm { const bf16_t* A; const bf16_t* Bt; int M, N, K; const bf16_t* A2; const bf16_t* Bt2; };

struct StaticOrder {
    int nM, nN, nwg, G, c;
    __host__ __device__ __forceinline__ void init(int M, int N, int G_, int c_) { nM = M / BM; nN = N / BM; nwg = nM * nN; G = G_; c = c_; }
    __host__ __device__ __forceinline__ bool next(int i, Unit& u) const {
        const long L = (long)i * G + c; if (L >= nwg) return false;
        int wgid = (int)L; { const int q = nwg / NXCD, r = nwg % NXCD, xcd = wgid % NXCD, off = wgid / NXCD; wgid = (xcd < r ? xcd * (q + 1) : r * (q + 1) + (xcd - r) * q) + off; }
        const int nig = WGM * nN, gid = wgid / nig, fm = gid * WGM, gsz = (nM - fm) < WGM ? (nM - fm) : WGM;
        u.pm = fm + ((wgid % nig) % gsz); u.pn = (wgid % nig) / gsz; return true;
    }
    __device__ __forceinline__ void a_ready(const Unit&) const {}
    __device__ __forceinline__ void done(const Unit&) const {}
};
__device__ __forceinline__ unsigned cvt_pk_bf16(float lo, float hi) { unsigned r; asm volatile("v_cvt_pk_bf16_f32 %0, %1, %2" : "=v"(r) : "v"(lo), "v"(hi)); return r; }
typedef float f32x2 __attribute__((ext_vector_type(2)));
__device__ __forceinline__ float sigm(float v) { return __builtin_amdgcn_rcpf(1.0f + __expf(-v)); }
__device__ __forceinline__ float bf_lo(unsigned w) { return __uint_as_float(w << 16); }
__device__ __forceinline__ float bf_hi(unsigned w) { return __uint_as_float(w & 0xffff0000u); }
__device__ __forceinline__ u32x4 pack8(f32x4 v0, f32x4 v1) { u32x4 w; w.x = cvt_pk_bf16(v0[0], v0[1]); w.y = cvt_pk_bf16(v0[2], v0[3]); w.z = cvt_pk_bf16(v1[0], v1[1]); w.w = cvt_pk_bf16(v1[2], v1[3]); return w; }
typedef unsigned u32x2 __attribute__((ext_vector_type(2)));
__device__ __forceinline__ f32x4 sig4(f32x4 a, float rneg) { f32x4 t = a * rneg, e; e[0] = __builtin_amdgcn_exp2f(t[0]); e[1] = __builtin_amdgcn_exp2f(t[1]); e[2] = __builtin_amdgcn_exp2f(t[2]); e[3] = __builtin_amdgcn_exp2f(t[3]);
    e = e + 1.0f; f32x4 o; o[0] = __builtin_amdgcn_rcpf(e[0]); o[1] = __builtin_amdgcn_rcpf(e[1]); o[2] = __builtin_amdgcn_rcpf(e[2]); o[3] = __builtin_amdgcn_rcpf(e[3]); return o; }

template <int CTRL> __device__ __forceinline__ float dpp_or1(float x) { return __builtin_bit_cast(float, __builtin_amdgcn_update_dpp(0x3f800000, __builtin_bit_cast(int, x), CTRL, 0xF, 0xF, false)); }
struct EpiInProj {
    static constexpr bool PERM = true, AFTER_DRAIN = false; static constexpr int SEAM_VMOPS = 16;
    bf16_t *Q, *K, *V, *QB, *IB, *SG, *GA, *GB, *KD; float* CL; const PG8_LAS float* tab; const float* lb; float* KMP;
    __device__ __forceinline__ void operator()(const f32x4 (&acc)[2][2][4][2], const Unit& u, int wr, int wc, int fr, int fq) const {
        const int seg = u.pn >> 2; const int rl0 = wr * 64 + fr, row0 = u.pm * BM + rl0;
        int mode = 0, ldc = 1024, colt = (u.pn & 3) * 256; bf16_t* ob = Q; const bool hm = (seg == 5 || seg == 6);
        constexpr size_t HMS = (size_t)2048 * 128;
        if (seg == 1) ob = K; else if (seg == 2) ob = V; else if (seg == 3 || seg == 4) mode = 4; else if (seg == 5) ob = IB; else if (seg == 6) { ob = SG; mode = 2; }
        else if (seg >= 7) { ob = GA; mode = 5; ldc = 2048; colt = (u.pn - 28) * 128; }
        const int col0 = colt + wc * 32 + 8 * fq;
        if (mode == 4) {
            const int h = u.pn - 12, dcol = wc * 32 + 8 * fq;
            f32x4 lbv[2];
#pragma unroll
            for (int n = 0; n < 2; ++n) lbv[n] = *(const f32x4*)(lb + h * 128 + dcol + 4 * n);
#pragma unroll
            for (int ai = 0; ai < 2; ++ai) {
                float rr[4]; u32x2 qp[4][2], kp[4][2];
#pragma unroll
                for (int m = 0; m < 4; ++m) rr[m] = tab[rl0 + ai * HALF + m * 16];
#pragma unroll
                for (int n = 0; n < 2; ++n) {
                    f32x4 fv[4], cp[4];
#pragma unroll
                    for (int m = 0; m < 4; ++m) { const f32x4 l = lbv[n]; fv[m] = l + (1.0f - l) * sig4(acc[ai][1][m][n], rr[m] * -1.4426950408889634f); }
#pragma unroll
                    for (int m = 0; m < 4; ++m)
#pragma unroll
                        for (int j = 0; j < 4; ++j) { float x = fv[m][j];
                            x *= dpp_or1<0x111>(x); x *= dpp_or1<0x112>(x); x *= dpp_or1<0x114>(x); x *= dpp_or1<0x118>(x); cp[m][j] = x; }
#pragma unroll
                    for (int j = 0; j < 4; ++j) { float e = 1.0f;
#pragma unroll
                        for (int m = 0; m < 4; ++m) { cp[m][j] *= e;
                            if (m < 3) { float t = fv[m][j]; t *= dpp_or1<0x128>(t); t *= dpp_or1<0x124>(t); t *= dpp_or1<0x122>(t); t *= dpp_or1<0x121>(t); e *= t; } } }
                    if (fr == 15) *(f32x4*)(CL + (size_t)((u.pm * BM + ai * HALF + wr * 64) >> 6) * 1024 + h * 128 + dcol + 4 * n) = cp[3];
#pragma unroll
                    for (int m = 0; m < 4; ++m) { const f32x4 qd = acc[ai][0][m][n] * rr[m] * cp[m]; f32x4 kd;
#pragma unroll
                        for (int j = 0; j < 4; ++j) kd[j] = (1.0f - fv[m][j]) * __builtin_amdgcn_rcpf(cp[m][j]);
                        qp[m][n].x = cvt_pk_bf16(qd[0], qd[1]); qp[m][n].y = cvt_pk_bf16(qd[2], qd[3]); kp[m][n].x = cvt_pk_bf16(kd[0], kd[1]); kp[m][n].y = cvt_pk_bf16(kd[2], kd[3]); }
                }
#pragma unroll
                for (int m = 0; m < 4; ++m) { const size_t off = (size_t)h * HMS + (size_t)(row0 + ai * HALF + m * 16) * 128 + dcol;
                    *(u32x4*)(QB + off) = (u32x4){qp[m][0].x, qp[m][0].y, qp[m][1].x, qp[m][1].y};
                    *(u32x4*)(KD + off) = (u32x4){kp[m][0].x, kp[m][0].y, kp[m][1].x, kp[m][1].y}; }
            }
        } else {
            if (seg == 1) {
                f32x4 cs[2][2];
#pragma unroll
                for (int bj = 0; bj < 2; ++bj)
#pragma unroll
                    for (int n = 0; n < 2; ++n) { f32x4 s = {0.f, 0.f, 0.f, 0.f};
#pragma unroll
                        for (int ai = 0; ai < 2; ++ai)
#pragma unroll
                            for (int m = 0; m < 4; ++m) s += acc[ai][bj][m][n] * tab[rl0 + ai * HALF + m * 16];
#pragma unroll
                        for (int o = 1; o < 16; o <<= 1) { s[0] += __shfl_xor(s[0], o); s[1] += __shfl_xor(s[1], o); s[2] += __shfl_xor(s[2], o); s[3] += __shfl_xor(s[3], o); }
                        cs[bj][n] = s; }
                if (fr == 0) {
#pragma unroll
                    for (int bj = 0; bj < 2; ++bj)
#pragma unroll
                        for (int n = 0; n < 2; ++n) *(f32x4*)(KMP + ((size_t)(((u.pm >> 3) * 8 + (2 * (u.pn & 3) + bj)) * 8 + (u.pm & 7)) * 2 + wr) * 128 + wc * 32 + 8 * fq + 4 * n) = cs[bj][n]; }
            }
#pragma unroll
            for (int ai = 0; ai < 2; ++ai)
#pragma unroll
                for (int m = 0; m < 4; ++m) { const int row = row0 + ai * HALF + m * 16; const float r = tab[rl0 + ai * HALF + m * 16]; bf16_t* rowp = hm ? ob + (size_t)(2 * (u.pn & 3)) * HMS + (size_t)row * 128 + wc * 32 + 8 * fq : ob + (size_t)row * ldc + col0;
                    { f32x4 v[2][2]; const float rneg = r * -1.4426950408889634f;
#pragma unroll
                      for (int bj = 0; bj < 2; ++bj) {
                        if (mode == 3 || mode == 5) { v[bj][0] = sig4(acc[ai][bj][m][0], rneg); v[bj][1] = sig4(acc[ai][bj][m][1], rneg); }
                        else { v[bj][0] = acc[ai][bj][m][0] * r; v[bj][1] = acc[ai][bj][m][1] * r; if (mode == 2) { v[bj][0] = v[bj][0] * sig4(acc[ai][bj][m][0], rneg); v[bj][1] = v[bj][1] * sig4(acc[ai][bj][m][1], rneg); } } }
                      if (mode == 5) {
#pragma unroll
                          for (int j = 0; j < 4; ++j) { v[0][0][j] *= __builtin_amdgcn_rcpf(v[1][0][j]); v[0][1][j] *= __builtin_amdgcn_rcpf(v[1][1][j]); } }
                      const size_t step = mode == 5 ? (size_t)(GB - GA) : (hm ? HMS : (size_t)HALF);
                      *(u32x4*)(rowp) = pack8(v[0][0], v[0][1]); *(u32x4*)(rowp + step) = pack8(v[1][0], v[1][1]); } }
        }
    }
};
struct EpiMix2 {
    static constexpr bool PERM = true, AFTER_DRAIN = false; static constexpr int SEAM_VMOPS = 16;
    bf16_t* MIX; const bf16_t* GA; const bf16_t* GB;
    __device__ __forceinline__ void mid(f32x4 (&acc)[2][2][4][2], const Unit& u, int wr, int wc, int fr, int fq) const {
        const int row0 = u.pm * BM + wr * 64 + fr, col0 = u.pn * BM + wc * 32 + 8 * fq;
        u32x4 ga[2][4][2];
#pragma unroll
        for (int ai = 0; ai < 2; ++ai)
#pragma unroll
            for (int m = 0; m < 4; ++m)
#pragma unroll
                for (int bj = 0; bj < 2; ++bj) ga[ai][m][bj] = *(const u32x4*)(GA + (size_t)(row0 + ai * HALF + m * 16) * 2048 + col0 + bj * HALF);
#pragma unroll
        for (int ai = 0; ai < 2; ++ai)
#pragma unroll
            for (int m = 0; m < 4; ++m)
#pragma unroll
                for (int bj = 0; bj < 2; ++bj) { const u32x4 g = ga[ai][m][bj]; f32x4& v0 = acc[ai][bj][m][0]; f32x4& v1 = acc[ai][bj][m][1];
                    v0[0] *= bf_lo(g.x); v0[1] *= bf_hi(g.x); v0[2] *= bf_lo(g.y); v0[3] *= bf_hi(g.y); v1[0] *= bf_lo(g.z); v1[1] *= bf_hi(g.z); v1[2] *= bf_lo(g.w); v1[3] *= bf_hi(g.w); }
        asm volatile("" ::: "memory");
    }
    __device__ __forceinline__ void operator()(const f32x4 (&acc)[2][2][4][2], const Unit& u, int wr, int wc, int fr, int fq) const {
        const int row0 = u.pm * BM + wr * 64 + fr, col0 = u.pn * BM + wc * 32 + 8 * fq;
        u32x4 gb[2][4][2];
#pragma unroll
        for (int ai = 0; ai < 2; ++ai)
#pragma unroll
            for (int m = 0; m < 4; ++m)
#pragma unroll
                for (int bj = 0; bj < 2; ++bj) gb[ai][m][bj] = *(const u32x4*)(GB + (size_t)(row0 + ai * HALF + m * 16) * 2048 + col0 + bj * HALF);
#pragma unroll
        for (int ai = 0; ai < 2; ++ai)
#pragma unroll
            for (int m = 0; m < 4; ++m)
#pragma unroll
                for (int bj = 0; bj < 2; ++bj) { const u32x4 g = gb[ai][m][bj]; f32x4 v0 = acc[ai][bj][m][0], v1 = acc[ai][bj][m][1];
                    v0[0] *= bf_lo(g.x); v0[1] *= bf_hi(g.x); v0[2] *= bf_lo(g.y); v0[3] *= bf_hi(g.y); v1[0] *= bf_lo(g.z); v1[1] *= bf_hi(g.z); v1[2] *= bf_lo(g.w); v1[3] *= bf_hi(g.w);
                    *(u32x4*)(MIX + (size_t)(row0 + ai * HALF + m * 16) * 2048 + col0 + bj * HALF) = pack8(v0, v1); }
        asm volatile("" ::: "memory");
    }
};
template <bool SS> struct EpiResid {
    static constexpr bool PERM = true, AFTER_DRAIN = false; static constexpr int SEAM_VMOPS = 16;
    const bf16_t* XI; bf16_t* XO; float* SSP;
    __device__ __forceinline__ void operator()(const f32x4 (&acc)[2][2][4][2], const Unit& u, int wr, int wc, int fr, int fq) const {
        const int row0 = u.pm * BM + wr * 64 + fr, col0 = u.pn * BM + wc * 32 + 8 * fq;
        u32x4 xin[2][4][2];
#pragma unroll
        for (int ai = 0; ai < 2; ++ai)
#pragma unroll
            for (int m = 0; m < 4; ++m)
#pragma unroll
                for (int bj = 0; bj < 2; ++bj) xin[ai][m][bj] = *(const u32x4*)(XI + (size_t)(row0 + ai * HALF + m * 16) * 2048 + col0 + bj * HALF);
#pragma unroll
        for (int ai = 0; ai < 2; ++ai)
#pragma unroll
            for (int m = 0; m < 4; ++m) { const int row = row0 + ai * HALF + m * 16; const size_t off = (size_t)row * 2048 + col0; float s = 0.f;
#pragma unroll
                for (int bj = 0; bj < 2; ++bj) { const u32x4 xi = xin[ai][m][bj]; f32x4 o0 = acc[ai][bj][m][0], o1 = acc[ai][bj][m][1];
                    o0[0] += bf_lo(xi.x); o0[1] += bf_hi(xi.x); o0[2] += bf_lo(xi.y); o0[3] += bf_hi(xi.y); o1[0] += bf_lo(xi.z); o1[1] += bf_hi(xi.z); o1[2] += bf_lo(xi.w); o1[3] += bf_hi(xi.w);
                    s += ((o0[0] * o0[0] + o0[1] * o0[1]) + (o0[2] * o0[2] + o0[3] * o0[3])) + ((o1[0] * o1[0] + o1[1] * o1[1]) + (o1[2] * o1[2] + o1[3] * o1[3]));
                    *(u32x4*)(XO + off + bj * HALF) = pack8(o0, o1); }
                if (SS) { s += __shfl_xor(s, 16); s += __shfl_xor(s, 32); if (fq == 0) SSP[(size_t)row * 32 + u.pn * 4 + wc] = s; } }
        asm volatile("" ::: "memory");
    }
};
struct EpiGateUp {
    static constexpr bool PERM = true, AFTER_DRAIN = false; static constexpr int SEAM_VMOPS = 8;
    bf16_t* ACT; const PG8_LAS float* tab; int ldc;
    __device__ __forceinline__ void operator()(const f32x4 (&acc)[2][2][4][2], const Unit& u, int wr, int wc, int fr, int fq) const {
        const int col0 = u.pn * 128 + wc * 32 + 8 * fq;
#pragma unroll
        for (int ai = 0; ai < 2; ++ai)
#pragma unroll
            for (int m = 0; m < 4; ++m) { const int rl = ai * HALF + wr * 64 + m * 16 + fr; const float r = tab[rl];
                f32x4 a0, a1;
#pragma unroll
                for (int j = 0; j < 4; ++j) { a0[j] = 0.f; a1[j] = 0.f; }
                { const float rneg = r * -1.4426950408889634f, r2 = r * r;
                  a0 = (acc[ai][0][m][0] * acc[ai][1][m][0]) * r2 * sig4(acc[ai][0][m][0], rneg); a1 = (acc[ai][0][m][1] * acc[ai][1][m][1]) * r2 * sig4(acc[ai][0][m][1], rneg); }
                *(u32x4*)(ACT + (size_t)(u.pm * BM + rl) * ldc + col0) = pack8(a0, a1); }
    }
};
struct EpiPle {
    static constexpr bool PERM = true, AFTER_DRAIN = false; static constexpr int SEAM_VMOPS = 0;
    bf16_t* O;
    __device__ __forceinline__ void operator()(const f32x4 (&acc)[2][2][4][2], const Unit& u, int wr, int wc, int fr, int fq) const {
        const int row0 = u.pm * BM + wr * 64 + fr, col0 = u.pn * BM + wc * 32 + 8 * fq;
#pragma unroll
        for (int ai = 0; ai < 2; ++ai)
#pragma unroll
            for (int m = 0; m < 4; ++m)
#pragma unroll
                for (int bj = 0; bj < 2; ++bj) *(u32x4*)(O + (size_t)(row0 + ai * HALF + m * 16) * 2048 + col0 + bj * HALF) = pack8(acc[ai][bj][m][0], acc[ai][bj][m][1]);
    }
};
struct EpiPleGate {
    static constexpr bool PERM = true, AFTER_DRAIN = false; static constexpr int SEAM_VMOPS = 8;
    const bf16_t* XI; bf16_t* XO; const bf16_t* PLE; float* SSP;
    __device__ __forceinline__ void operator()(const f32x4 (&acc)[2][2][4][2], const Unit& u, int wr, int wc, int fr, int fq) const {
        const int row0 = u.pm * BM + wr * 64 + fr, col0 = u.pn * BM + wc * 32 + 8 * fq;
        u32x4 xin[2][2][2], pin[2][2][2];
#define PGT_LOAD(q) do { _Pragma("unroll") for (int m2 = 0; m2 < 2; ++m2) _Pragma("unroll") for (int bj = 0; bj < 2; ++bj) { const unsigned o_ = (unsigned)(row0 + ((q) >> 1) * HALF + (2 * ((q) & 1) + m2) * 16) * 2048u + (unsigned)(col0 + bj * HALF); \
            xin[(q) & 1][m2][bj] = *(const u32x4*)(XI + o_); pin[(q) & 1][m2][bj] = *(const u32x4*)(PLE + o_); } } while (0)
#define PGT_E(av, xw, pw, lo) ((lo ? bf_lo(xw) : bf_hi(xw)) + sigm(av) * (lo ? bf_lo(pw) : bf_hi(pw)))
#define PGT_COMP(q) do { _Pragma("unroll") for (int m2 = 0; m2 < 2; ++m2) { const int m = 2 * ((q) & 1) + m2; const int row = row0 + ((q) >> 1) * HALF + m * 16; const unsigned off = (unsigned)row * 2048u + (unsigned)col0; float s = 0.f; \
            _Pragma("unroll") for (int bj = 0; bj < 2; ++bj) { const f32x4 a0 = acc[(q) >> 1][bj][m][0], a1 = acc[(q) >> 1][bj][m][1]; const u32x4 xi = xin[(q) & 1][m2][bj], pl = pin[(q) & 1][m2][bj]; f32x4 o0, o1; \
                o0[0] = PGT_E(a0[0], xi.x, pl.x, true); o0[1] = PGT_E(a0[1], xi.x, pl.x, false); o0[2] = PGT_E(a0[2], xi.y, pl.y, true); o0[3] = PGT_E(a0[3], xi.y, pl.y, false); \
                o1[0] = PGT_E(a1[0], xi.z, pl.z, true); o1[1] = PGT_E(a1[1], xi.z, pl.z, false); o1[2] = PGT_E(a1[2], xi.w, pl.w, true); o1[3] = PGT_E(a1[3], xi.w, pl.w, false); \
                s += ((o0[0] * o0[0] + o0[1] * o0[1]) + (o0[2] * o0[2] + o0[3] * o0[3])) + ((o1[0] * o1[0] + o1[1] * o1[1]) + (o1[2] * o1[2] + o1[3] * o1[3])); \
                *(u32x4*)(XO + off + bj * HALF) = pack8(o0, o1); } \
            s += __shfl_xor(s, 16); s += __shfl_xor(s, 32); if (fq == 0) SSP[(size_t)row * 32 + u.pn * 4 + wc] = s; } } while (0)
        PGT_LOAD(0); PGT_LOAD(1);
        PGT_COMP(0); asm volatile("" ::: "memory"); PGT_LOAD(2);
        PGT_COMP(1); asm volatile("" ::: "memory"); PGT_LOAD(3);
        PGT_COMP(2); asm volatile("" ::: "memory");
        PGT_COMP(3); asm volatile("" ::: "memory");
#undef PGT_LOAD
#undef PGT_E
#undef PGT_COMP
    }
};

struct EpiNull {
    static constexpr bool PERM = true, AFTER_DRAIN = false; static constexpr int SEAM_VMOPS = 0;
    __device__ __forceinline__ void operator()(const f32x4 (&acc)[2][2][4][2], const Unit& u, int wr, int wc, int fr, int fq) const {
#pragma unroll
        for (int ai = 0; ai < 2; ++ai)
#pragma unroll
            for (int bj = 0; bj < 2; ++bj)
#pragma unroll
                for (int m = 0; m < 4; ++m)
#pragma unroll
                    for (int n = 0; n < 2; ++n) asm volatile("" :: "v"(acc[ai][bj][m][n]));
    }
};
struct SameTileOrder { int n; __device__ __forceinline__ bool next(int i, Unit& u) const { if (i >= n) return false; u.pm = 0; u.pn = 0; return true; }
    __device__ __forceinline__ void a_ready(const Unit&) const {} __device__ __forceinline__ void done(const Unit&) const {} };
template <class Epi, class Sched, bool ALIGN_EPI = false, bool SP2 = false, bool DUAL = false>
__device__ __forceinline__ void gemm_phase(PG8_LAS unsigned char* lds, const Gemm g, const Sched& S, const Epi& E) {
    int tid_ = threadIdx.x; asm volatile("" : "+v"(tid_));
    const int tid = tid_, wid = __builtin_amdgcn_readfirstlane(tid >> 6), lane = tid & 63, wr = wid >> 2, wc = wid & 3, fr = lane & 15, fq = lane >> 4;
    const int K = g.K, nt = K / BK;
    unsigned voffA[2], voffB[2];
#pragma unroll
    for (int i = 0; i < 2; ++i) { int R, C; stage_rc(tid * 16 + i * 8192, R, C); const int Rb = Epi::PERM ? ((R & ~31) + perm32(R & 31)) : R;
        voffA[i] = (unsigned)(R * K + C) * 2u; voffB[i] = (unsigned)(Rb * K + C) * 2u; }
    const size_t kstep = (size_t)(BK * 2);
    const size_t hstep = (size_t)HALF * K * 2;
    const size_t tstep = 2 * hstep;
    const unsigned ldsw = (unsigned)wid * 1024u;
    const int aoff = lds_byte(wr * 64 + fr, fq * 8), boff = lds_byte(wc * 32 + fr, fq * 8);
#define PG8_SA(b, h) (((b) * 2 + (h)) * HTB)
#define PG8_SB(b, h) ((4 + (b) * 2 + (h)) * HTB)
#define PG8_STAGE(bufoff, gbase, voff) do { _Pragma("unroll") for (int _i = 0; _i < 2; ++_i) \
        __builtin_amdgcn_global_load_lds((const unsigned*)((const char*)(gbase) + (voff)[_i]), (PG8_LAS unsigned*)(lds + (bufoff) + ldsw + _i * 8192), 16, 0, 0); } while (0)
#define PG8_LDA(dst, b, h) do { _Pragma("unroll") for (int m = 0; m < 4; ++m) _Pragma("unroll") for (int k = 0; k < 2; ++k) dst[m][k] = *(const PG8_LAS bf16x8*)(lds + PG8_SA(b, h) + aoff + m * 2048 + k * 1024); } while (0)
#define PG8_LDB(dst, b, h) do { _Pragma("unroll") for (int n = 0; n < 2; ++n) _Pragma("unroll") for (int k = 0; k < 2; ++k) dst[n][k] = *(const PG8_LAS bf16x8*)(lds + PG8_SB(b, h) + boff + n * 2048 + k * 1024); } while (0)
#define PG8_MMA(ai, bj, At, Bt) do { __builtin_amdgcn_s_setprio(1); _Pragma("unroll") for (int m = 0; m < 4; ++m) _Pragma("unroll") for (int n = 0; n < 2; ++n) _Pragma("unroll") for (int k = 0; k < 2; ++k) \
        acc[ai][bj][m][n] = __builtin_amdgcn_mfma_f32_16x16x32_bf16(Bt[n][k], At[m][k], acc[ai][bj][m][n], 0, 0, 0); __builtin_amdgcn_s_setprio(0); } while (0)
#define PG8_WAIT_V(n) asm volatile("s_waitcnt vmcnt(" #n ")" ::: "memory")
#define PG8_WAIT_VI(n) asm volatile("s_waitcnt vmcnt(%0)" :: "i"(n) : "memory")
#define PG8_WAIT_L(n) asm volatile("s_waitcnt lgkmcnt(" #n ")" ::: "memory")
#define PG8_BAR __builtin_amdgcn_s_barrier()
#define PG8_SCHED __builtin_amdgcn_sched_barrier(0)
    Unit cur, nxt; int ui = 0;
    if (!S.next(0, cur)) return;
    f32x4 acc[2][2][4][2];
#pragma unroll
    for (int a = 0; a < 2; ++a)
#pragma unroll
        for (int b = 0; b < 2; ++b)
#pragma unroll
            for (int m = 0; m < 4; ++m)
#pragma unroll
                for (int n = 0; n < 2; ++n) acc[a][b][m][n] = (f32x4){0.f, 0.f, 0.f, 0.f};
    bf16x8 At[4][2], B0[2][2], B1[2][2];
    const char* cA = (const char*)g.A + (size_t)cur.pm * tstep; const char* cB = (const char*)g.Bt + (size_t)cur.pn * tstep;
    S.a_ready(cur);
    if constexpr (SP2) {
        PG8_STAGE(PG8_SB(0, 0), cB, voffB); PG8_STAGE(PG8_SB(0, 1), cB + hstep, voffB); PG8_STAGE(PG8_SA(0, 0), cA, voffA); PG8_STAGE(PG8_SA(0, 1), cA + hstep, voffA);
        if (wr == 1) PG8_BAR;
        PG8_WAIT_V(2); PG8_BAR;
        PG8_STAGE(PG8_SB(1, 0), cB + kstep, voffB); PG8_STAGE(PG8_SA(1, 0), cA + kstep, voffA); PG8_STAGE(PG8_SB(1, 1), cB + hstep + kstep, voffB);
        PG8_WAIT_V(6); PG8_BAR;
    } else {
        PG8_STAGE(PG8_SB(0, 0), cB, voffB); PG8_STAGE(PG8_SA(0, 0), cA, voffA); PG8_STAGE(PG8_SB(0, 1), cB + hstep, voffB); PG8_STAGE(PG8_SA(0, 1), cA + hstep, voffA);
        if (wr == 1) PG8_BAR;
        PG8_WAIT_V(4); PG8_BAR;
        PG8_STAGE(PG8_SB(1, 0), cB + kstep, voffB); PG8_STAGE(PG8_SA(1, 0), cA + kstep, voffA); PG8_STAGE(PG8_SB(1, 1), cB + hstep + kstep, voffB);
        PG8_WAIT_V(6); PG8_BAR;
    }
    for (;;) {
        const bool has_next = S.next(DUAL ? ((ui + 1) >> 1) : (ui + 1), nxt);
        const bf16_t* nAm = (DUAL && ((ui + 1) & 1)) ? g.A2 : g.A; const bf16_t* nBm = (DUAL && ((ui + 1) & 1)) ? g.Bt2 : g.Bt;
        const char* nA = has_next ? (const char*)nAm + (size_t)nxt.pm * tstep : cA; const char* nB = has_next ? (const char*)nBm + (size_t)nxt.pn * tstep : cB;
        for (int t = 0; t < nt; t += 2) {
            const bool last = (t == nt - 2);
            const char* a1 = cA + (size_t)(t + 1) * kstep;
            const char* a2 = last ? nA : cA + (size_t)(t + 2) * kstep; const char* b2 = last ? nB : cB + (size_t)(t + 2) * kstep;
            const char* a3 = a2 + kstep; const char* b3 = b2 + kstep;
            if (last && has_next) S.a_ready(nxt);
            if constexpr (SP2) {
            int rl = __builtin_amdgcn_readfirstlane((Epi::SEAM_VMOPS > 0 && t == 0 && ui > 0) ? 1 : 0); if (Epi::SEAM_VMOPS > 0) asm volatile("" : "+s"(rl));
            PG8_LDB(B0, 0, 0); PG8_LDB(B1, 0, 1); PG8_SCHED; PG8_LDA(At, 0, 0); PG8_STAGE(PG8_SA(1, 1), a1 + hstep, voffA);
            if (Epi::SEAM_VMOPS > 0 && rl) PG8_WAIT_VI(8 + Epi::SEAM_VMOPS); else PG8_WAIT_V(8);
            PG8_WAIT_L(0); PG8_BAR; PG8_MMA(0, 0, At, B0); PG8_MMA(0, 1, At, B1); PG8_BAR; PG8_SCHED;
            PG8_LDA(At, 0, 1); PG8_STAGE(PG8_SB(0, 0), b2, voffB); PG8_STAGE(PG8_SB(0, 1), b2 + hstep, voffB); PG8_STAGE(PG8_SA(0, 0), a2, voffA);
            if (Epi::SEAM_VMOPS > 0 && rl) PG8_WAIT_VI(8 + Epi::SEAM_VMOPS); else PG8_WAIT_V(8);
            PG8_WAIT_L(0); PG8_BAR; PG8_MMA(1, 0, At, B0); PG8_MMA(1, 1, At, B1); PG8_BAR; PG8_SCHED;
            PG8_LDB(B0, 1, 0); PG8_LDB(B1, 1, 1); PG8_SCHED; PG8_LDA(At, 1, 0); PG8_STAGE(PG8_SA(0, 1), a2 + hstep, voffA);
            PG8_WAIT_V(8); PG8_WAIT_L(0); PG8_BAR; PG8_MMA(0, 0, At, B0); PG8_MMA(0, 1, At, B1); PG8_BAR; PG8_SCHED;
            PG8_LDA(At, 1, 1); PG8_STAGE(PG8_SB(1, 0), b3, voffB); PG8_STAGE(PG8_SB(1, 1), b3 + hstep, voffB); PG8_STAGE(PG8_SA(1, 0), a3, voffA);
            PG8_WAIT_V(8); PG8_WAIT_L(0); PG8_BAR; PG8_MMA(1, 0, At, B0); PG8_MMA(1, 1, At, B1); PG8_BAR; PG8_SCHED;
            } else {
            PG8_LDB(B0, 0, 0); PG8_SCHED; PG8_LDA(At, 0, 0); PG8_STAGE(PG8_SA(1, 1), a1 + hstep, voffA);
            PG8_WAIT_L(8); PG8_BAR; PG8_WAIT_L(0); PG8_MMA(0, 0, At, B0); PG8_BAR; PG8_SCHED;
            PG8_LDB(B1, 0, 1); PG8_STAGE(PG8_SB(0, 0), b2, voffB);
            PG8_BAR; PG8_WAIT_L(0); PG8_MMA(0, 1, At, B1); PG8_BAR;
            PG8_LDA(At, 0, 1); PG8_STAGE(PG8_SA(0, 0), a2, voffA);
            PG8_BAR; PG8_WAIT_L(0); PG8_MMA(1, 0, At, B0); PG8_BAR; PG8_SCHED;
            PG8_STAGE(PG8_SB(0, 1), b2 + hstep, voffB);
            PG8_WAIT_V(6); PG8_BAR; PG8_MMA(1, 1, At, B1); PG8_BAR;
            PG8_LDB(B0, 1, 0); PG8_SCHED; PG8_LDA(At, 1, 0); PG8_STAGE(PG8_SA(0, 1), a2 + hstep, voffA);
            PG8_WAIT_L(8); PG8_BAR; PG8_WAIT_L(0); PG8_MMA(0, 0, At, B0); PG8_BAR; PG8_SCHED;
            PG8_LDB(B1, 1, 1); PG8_STAGE(PG8_SB(1, 0), b3, voffB);
            PG8_BAR; PG8_WAIT_L(0); PG8_MMA(0, 1, At, B1); PG8_BAR;
            PG8_LDA(At, 1, 1); PG8_STAGE(PG8_SA(1, 0), a3, voffA);
            PG8_BAR; PG8_WAIT_L(0); PG8_MMA(1, 0, At, B0); PG8_BAR; PG8_SCHED;
            PG8_STAGE(PG8_SB(1, 1), b3 + hstep, voffB);
            PG8_WAIT_V(6); PG8_BAR; PG8_MMA(1, 1, At, B1); PG8_BAR;
            }
        }
        if constexpr (ALIGN_EPI) { if (wr == 0) PG8_BAR; }
        const bool keep = DUAL && !(ui & 1);
        if constexpr (DUAL) { if (keep) E.mid(acc, cur, wr, wc, fr, fq); else { E(acc, cur, wr, wc, fr, fq); S.done(cur); } }
        else if constexpr (!Epi::AFTER_DRAIN) { E(acc, cur, wr, wc, fr, fq); S.done(cur); }
        if (!has_next) break;
        if (!keep) {
#pragma unroll
        for (int a = 0; a < 2; ++a)
#pragma unroll
            for (int b = 0; b < 2; ++b)
#pragma unroll
                for (int m = 0; m < 4; ++m)
#pragma unroll
                    for (int n = 0; n < 2; ++n) acc[a][b][m][n] = (f32x4){0.f, 0.f, 0.f, 0.f};
        }
        cur = nxt; cA = nA; cB = nB; ++ui;
        if constexpr (ALIGN_EPI) { if (wr == 1) PG8_BAR; }
    }
    PG8_WAIT_V(0);
    if constexpr (!ALIGN_EPI) { if (wr == 0) PG8_BAR; }
    PG8_BAR;
    if constexpr (Epi::AFTER_DRAIN) { E.fused(acc, cur, wr, wc, fr, fq, lds, wid, lane); S.done(cur); }
#undef PG8_SA
#undef PG8_SB
#undef PG8_STAGE
#undef PG8_LDA
#undef PG8_LDB
#undef PG8_MMA
#undef PG8_WAIT_V
#undef PG8_WAIT_VI
#undef PG8_WAIT_L
#undef PG8_BAR
#undef PG8_SCHED
}
}
#ifndef PG8_SP2
#define PG8_SP2 true
#endif
#ifndef PG8_ALIGN
#define PG8_ALIGN true
#endif
constexpr int NWAVES = 8;
#ifndef MK_N_LAUNCHES
#define MK_N_LAUNCHES 1
#endif
constexpr int N_PHASES = 10;
constexpr int N_LAUNCHES = MK_N_LAUNCHES;

constexpr int BATCH = 8, SEQ = 2048, DM = 2048, M = BATCH * SEQ;
constexpr int NH = 8, HD = 128, AW = 1024, MBLK = 256, NBLK = SEQ / MBLK;
constexpr int DFF = 5632, PLED = 256, INW = 11264;
constexpr float NORM_EPS = 1e-6f;

constexpr size_t MiB = 1u << 20;
constexpr size_t WS_CTL = 0, CTL_ZERO_BYTES = 32768;
constexpr size_t WS_RSTD0 = 1 * MiB, WS_LB = WS_RSTD0 + 65536, WS_TB = WS_LB + 4096, WS_KMEAN = WS_RSTD0 + 131072;
constexpr size_t WS_SS1 = 2 * MiB, WS_SS3 = 4 * MiB;
constexpr size_t WS_WIN = 8 * MiB, WS_WGU = 52 * MiB, WS_WDN = 96 * MiB, WS_WOUT = 118 * MiB, WS_WPG = 126 * MiB, WS_WA = 134 * MiB, WS_WB = 138 * MiB, WS_WPLE = 142 * MiB;
constexpr size_t WS_PB = 143 * MiB;
constexpr size_t WS_RA = 152 * MiB;
constexpr size_t WS_ARENA = 216 * MiB, ARENA_STRIDE = 36 * MiB;
constexpr size_t AO_Q = 0, AO_QB = 4 * MiB, AO_K = 8 * MiB, AO_V = 12 * MiB, AO_F = 16 * MiB, AO_IB = 24 * MiB, AO_SG = 28 * MiB;
constexpr size_t AO_KD = AO_F, AO_CL = AO_F + 4 * MiB;
constexpr size_t AO_YA = AO_Q, AO_YB = 32 * MiB, AO_ACT = AO_K, AO_PLE = AO_ACT, AO_X3B = AO_PLE + 8 * MiB, WS_END = WS_ARENA + 8 * ARENA_STRIDE;
static_assert(AO_ACT + (size_t)SEQ * DFF * 2 <= ARENA_STRIDE && AO_X3B + (size_t)SEQ * DM * 2 <= AO_ACT + (size_t)SEQ * DFF * 2 && WS_RA + (size_t)M * DM * 2 <= WS_ARENA && WS_END <= 504 * MiB, "d_ws map");
constexpr int CW_GRP = 512, CW_GRPX = 1536, CW_LATE = 2560, CW_PNL = 3072;
constexpr int CW_BAR = 4096;

constexpr int RING_OFF = 0, RING_BYTES = 131072;
constexpr int LDSCTL_OFF = RING_BYTES, MISC_OFF = LDSCTL_OFF + 320, TAB_OFF = LDSCTL_OFF + 1024;
constexpr int LDS_BYTES = 147456;
static_assert(TAB_OFF + 1024 <= LDS_BYTES, "LDS map");
#define GAS __attribute__((address_space(1)))
#define LAS __attribute__((address_space(3)))
typedef unsigned short bf16;
typedef unsigned v4u __attribute__((ext_vector_type(4)));
typedef float f32x4 __attribute__((ext_vector_type(4)));
typedef short bf16x8 __attribute__((ext_vector_type(8)));
typedef GAS unsigned gu32;
typedef GAS unsigned long long gu64;
#define RLX_AGENT __ATOMIC_RELAXED, __HIP_MEMORY_SCOPE_AGENT
#define LDS_WAIT() asm volatile("s_waitcnt lgkmcnt(0)" ::: "memory")
#define VM_WAIT() asm volatile("s_waitcnt vmcnt(0)" ::: "memory")
__device__ __forceinline__ unsigned long long rt() { return __builtin_amdgcn_s_memrealtime(); }
__device__ __forceinline__ unsigned f2bf(float f) { unsigned u = __builtin_bit_cast(unsigned, f); return (u + 0x7fffu + ((u >> 16) & 1u)) >> 16; }
__device__ __forceinline__ float dpp_xor1(float v) { return __builtin_bit_cast(float, __builtin_amdgcn_mov_dpp(__builtin_bit_cast(int, v), 0xB1, 0xF, 0xF, true)); }
__device__ __forceinline__ float dpp_xor2(float v) { return __builtin_bit_cast(float, __builtin_amdgcn_mov_dpp(__builtin_bit_cast(int, v), 0x4E, 0xF, 0xF, true)); }
__device__ __forceinline__ unsigned pk2(float lo, float hi) { unsigned r; asm volatile("v_cvt_pk_bf16_f32 %0, %1, %2" : "=v"(r) : "v"(lo), "v"(hi)); return r; }

#define XB_TMO      128
#define XB_XCNT(j)  (256  + 64 * (j))
#define XB_XSUB(j)  (1280 + 64 * (j))
#define XB_XGEN(j)  (2304 + 64 * (j))
#define XB_TOP      3328
#define XB_TOPGEN   3392
#define XCD_BAR_WORDS 3456
#define XB_SPIN_CAP (1u << 18)

__device__ __forceinline__ unsigned xb_ld(unsigned* p)              { return __hip_atomic_load(p, __ATOMIC_RELAXED, __HIP_MEMORY_SCOPE_AGENT); }
__device__ __forceinline__ unsigned xb_add(unsigned* p, unsigned v) { return __hip_atomic_fetch_add(p, v, __ATOMIC_RELAXED, __HIP_MEMORY_SCOPE_AGENT); }
__device__ __forceinline__ unsigned xb_xcc_id() { return (unsigned)__builtin_amdgcn_s_getreg((3 << 11) | 20) & 0xFu; }
#define XB_SPIN(cond, bar) do { unsigned _sp = 0; while (cond) { __builtin_amdgcn_s_sleep(1); \
    if ((++_sp & 255u) == 0u) { if (xb_ld(&(bar)[XB_TMO])) break; if (_sp > XB_SPIN_CAP) { atomicAdd(&(bar)[XB_TMO], 1u); break; } } } } while (0)

struct XcdBarrier {
    unsigned* bar; unsigned x;
    volatile LAS unsigned* st;
};

__device__ __forceinline__ XcdBarrier xcd_barrier_post(unsigned* bar, volatile LAS unsigned* st) {
    XcdBarrier b; b.bar = bar; b.x = xb_xcc_id(); b.st = st;
    if (threadIdx.x == 0) (void)xb_add(&bar[XB_XCNT(b.x)], 1u);
    return b;
}
__device__ __forceinline__ void xcd_barrier_complete(unsigned* bar, unsigned x, unsigned& nloc, unsigned& nx) {
    const unsigned G = gridDim.x * gridDim.y * gridDim.z;
    unsigned sum, cnt, mine, sp = 0u;
    for (;;) {
        sum = 0u; cnt = 0u; mine = 0u;
#pragma unroll
        for (unsigned j = 0; j < 16; ++j) { const unsigned c = xb_ld(&bar[XB_XCNT(j)]); sum += c; cnt += (c > 0u) ? 1u : 0u; mine = (j == x) ? c : mine; }
        if (sum == G) break;
        __builtin_amdgcn_s_sleep(1);
        if ((++sp & 255u) == 0u) { if (xb_ld(&bar[XB_TMO])) break; if (sp > XB_SPIN_CAP) { atomicAdd(&bar[XB_TMO], 1u); break; } }
    }
    nloc = mine > 0u ? mine : 1u; nx = cnt > 0u ? cnt : 1u;
}

__device__ __forceinline__ void xcd_barrier(const XcdBarrier& b) {
    asm volatile("s_waitcnt vmcnt(0)" ::: "memory");
    __syncthreads();
    if (threadIdx.x == 0) {
        unsigned* bar = b.bar;
        __builtin_amdgcn_s_waitcnt(0);
        unsigned nloc = b.st[0], nx = b.st[1];
        if (nloc == 0u) { xcd_barrier_complete(bar, b.x, nloc, nx); b.st[0] = nloc; b.st[1] = nx; }
        const unsigned old = xb_add(&bar[XB_XSUB(b.x)], 1u);
        const unsigned gen = old / nloc;
        if (old + 1u == (gen + 1u) * nloc) {
            __builtin_amdgcn_fence(__ATOMIC_RELEASE, "agent");
            asm volatile("s_waitcnt vmcnt(0)" ::: "memory");
            const unsigned og = xb_add(&bar[XB_TOP], 1u);
            const unsigned tg = og / nx;
            if (og + 1u == (tg + 1u) * nx) xb_add(&bar[XB_TOPGEN], 1u);
            else XB_SPIN(xb_ld(&bar[XB_TOPGEN]) == tg, bar);
            __builtin_amdgcn_fence(__ATOMIC_ACQUIRE, "agent");
            xb_add(&bar[XB_XGEN(b.x)], 1u);
            asm volatile("s_waitcnt vmcnt(0)" ::: "memory");
        } else {
            XB_SPIN(xb_ld(&bar[XB_XGEN(b.x)]) == gen, bar);
            __builtin_amdgcn_fence(__ATOMIC_ACQUIRE, "agent");
            asm volatile("s_waitcnt vmcnt(0)" ::: "memory");
        }
    }
    __syncthreads();
}

struct GrpBar { unsigned* cnt; unsigned tgt, n; int light; };
__device__ __forceinline__ void grp_barrier(GrpBar& g, unsigned* bar, unsigned* late) {
    asm volatile("s_waitcnt vmcnt(0)" ::: "memory");
    __syncthreads();
    g.tgt += g.n;
    if (threadIdx.x == 0) {
        __builtin_amdgcn_s_waitcnt(0);
        if (!g.light) { __builtin_amdgcn_fence(__ATOMIC_RELEASE, "agent"); asm volatile("s_waitcnt vmcnt(0)" ::: "memory"); }
        if (late && !g.light) (void)xb_add(late, 1u);
        (void)xb_add(g.cnt, 1u);
        XB_SPIN(xb_ld(g.cnt) < g.tgt, bar);
        __builtin_amdgcn_fence(__ATOMIC_ACQUIRE, "agent");
        asm volatile("s_waitcnt vmcnt(0)" ::: "memory");
        if (late && g.light && (blockIdx.x >> 3) == 8) { __builtin_amdgcn_fence(__ATOMIC_RELEASE, "agent"); asm volatile("s_waitcnt vmcnt(0)" ::: "memory"); (void)xb_add(late, g.n); }
    }
    __syncthreads();
}
__device__ __forceinline__ void late_wait(unsigned* late, unsigned n, unsigned* bar) {
    if (threadIdx.x == 0) { XB_SPIN(xb_ld(late) < n, bar); __builtin_amdgcn_fence(__ATOMIC_ACQUIRE, "agent"); asm volatile("s_waitcnt vmcnt(0)" ::: "memory"); }
    __syncthreads();
}
__device__ __forceinline__ float wave_sum(float v) {
#pragma unroll
    for (int o = 1; o < 64; o <<= 1) v += __shfl_xor(v, o);
    return v;
}
namespace att {
typedef short s16x4 __attribute__((ext_vector_type(4)));
typedef float f32x16 __attribute__((ext_vector_type(16)));
constexpr int PITCH = 1024, SHM_K = 16384, SHM_V = 16384;
constexpr int L_V = 0, L_K = 2 * SHM_V, L_WS = L_K + 2 * SHM_K, L_KM = L_WS + 8 * 256, L_SEL = L_KM + 4096, L_TB = L_SEL + 1024, L_END = L_TB + 1024;
constexpr float SCALE = 0.08838834764831845f;
#define KSWZ(row, colB) ((row) * 256 + ((colB) ^ (((row) & 7) << 4)))
#define SBAR() __builtin_amdgcn_sched_barrier(0)
__device__ __forceinline__ int v_st(int k, int c) { const int kk = (k & ~0xC) | ((k & 4) << 1) | ((k & 8) >> 1); return ((kk >> 3) * 4 + (c >> 5)) * 512 + ((kk & 7) * 32 + (c & 31)) * 2; }
__device__ __forceinline__ int v_rd_base(int lane) { return ((lane & 3) << 3) | (((lane >> 2) & 3) << 6) | (((lane >> 4) & 1) << 5) | (((lane >> 5) & 1) << 8); }
constexpr int v_rd_off(int d0, int ks, int half) { return d0 * 512 + ks * 4096 + half * 2048; }
__device__ __forceinline__ int crow(int r, int hi) { return (r & 3) + 8 * (r >> 2) + 4 * hi; }
__device__ __forceinline__ unsigned cvtpk(float lo, float hi) { unsigned r; asm volatile("v_cvt_pk_bf16_f32 %0, %1, %2" : "=v"(r) : "v"(lo), "v"(hi)); return r; }

constexpr float THR = 8.f;
__device__ __forceinline__ void partialSM(f32x16& p0, f32x16& p1, float& m_reg, float& mn, float& alpha) {
    float pmax = p0[0];
#pragma unroll
    for (int r = 1; r < 16; ++r) pmax = fmaxf(pmax, p0[r]);
#pragma unroll
    for (int r = 0; r < 16; ++r) pmax = fmaxf(pmax, p1[r]);
    { auto rr = __builtin_amdgcn_permlane32_swap(__float_as_uint(pmax), __float_as_uint(pmax), false, false);
      pmax = fmaxf(__uint_as_float(rr[0]), __uint_as_float(rr[1])); }
    constexpr float C2 = 1.4426950408889634f * SCALE;
    if (__builtin_expect(__all((pmax - m_reg) * SCALE <= THR), 1)) { mn = m_reg; alpha = 1.f; }
    else { mn = fmaxf(m_reg, pmax); alpha = __builtin_amdgcn_exp2f((m_reg - mn) * C2); m_reg = mn; }
    const float mnL = -mn * C2;
#pragma unroll
    for (int r = 0; r < 16; ++r) p0[r] = fmaf(p0[r], C2, mnL);
#pragma unroll
    for (int r = 0; r < 16; ++r) p1[r] = fmaf(p1[r], C2, mnL);
#pragma unroll
    for (int r = 0; r < 16; ++r) p0[r] = __builtin_amdgcn_exp2f(p0[r]);
}
__device__ __forceinline__ void pack_p(const f32x16& p0, const f32x16& p1, bf16x8& pa0, bf16x8& pa1, bf16x8& pa2, bf16x8& pa3) {
#define PK4(P, B_, OUT) do { unsigned a0 = cvtpk(P[B_+0], P[B_+1]), a1 = cvtpk(P[B_+2], P[B_+3]);                          \
        unsigned b0 = cvtpk(P[B_+4], P[B_+5]), b1 = cvtpk(P[B_+6], P[B_+7]);                                             \
        auto r0 = __builtin_amdgcn_permlane32_swap(a0, b0, false, false); auto r1 = __builtin_amdgcn_permlane32_swap(a1, b1, false, false); \
        v4u w = {r0[0], r1[0], r0[1], r1[1]}; OUT = *reinterpret_cast<bf16x8*>(&w); } while (0)
    PK4(p0, 0, pa0); PK4(p0, 8, pa1); PK4(p1, 0, pa2); PK4(p1, 8, pa3);
#undef PK4
}
__device__ __forceinline__ void finishSM(f32x16& p0, f32x16& p1, float alpha, float& l_reg, bf16x8& pa0, bf16x8& pa1, bf16x8& pa2, bf16x8& pa3) {
#pragma unroll
    for (int r = 0; r < 16; ++r) p1[r] = __builtin_amdgcn_exp2f(p1[r]);
    float ps = 0;
#pragma unroll
    for (int r = 0; r < 16; ++r) ps += p0[r];
#pragma unroll
    for (int r = 0; r < 16; ++r) ps += p1[r];
    { auto rr = __builtin_amdgcn_permlane32_swap(__float_as_uint(ps), __float_as_uint(ps), false, false);
      ps = __uint_as_float(rr[0]) + __uint_as_float(rr[1]); }
    l_reg = l_reg * alpha + ps;
    pack_p(p0, p1, pa0, pa1, pa2, pa3);
}
__device__ __forceinline__ void qkt(f32x16& p0, f32x16& p1, const LAS char* Kb, int r32, int hi, const bf16x8* qr) {
    p0 = f32x16{}; p1 = f32x16{};
    const LAS char* kb[4];
#pragma unroll
    for (int dd = 0; dd < 4; ++dd) kb[dd] = Kb + KSWZ(r32, (dd * 16 + hi * 8) * 2);
#pragma unroll
    for (int d0 = 0; d0 < 8; ++d0) { const LAS char* a = kb[d0 & 3] + (d0 >> 2) * 128;
        const bf16x8 b0 = *reinterpret_cast<const LAS bf16x8*>(a);
        const bf16x8 b1 = *reinterpret_cast<const LAS bf16x8*>(a + 32 * 256);
        p0 = __builtin_amdgcn_mfma_f32_32x32x16_bf16(b0, qr[d0], p0, 0, 0, 0);
        p1 = __builtin_amdgcn_mfma_f32_32x32x16_bf16(b1, qr[d0], p1, 0, 0, 0); }
}
__device__ __forceinline__ void pv_tile(f32x16* o, int vb0, bf16x8 pa0, bf16x8 pa1, bf16x8 pa2, bf16x8 pa3) {
#define TRRD(dst, off) asm volatile("ds_read_b64_tr_b16 %0, %1 offset:%2" : "=&v"(dst) : "v"(vb0), "i"(off) : "memory")
#define PV_D0(d0) do { s16x4 l0, l1, l2, l3, h0, h1, h2, h3; constexpr int b_ = v_rd_off(d0, 0, 0); \
        TRRD(l0, b_); TRRD(h0, b_ + 2048); TRRD(l1, b_ + 4096); TRRD(h1, b_ + 6144); TRRD(l2, b_ + 8192); TRRD(h2, b_ + 10240); TRRD(l3, b_ + 12288); TRRD(h3, b_ + 14336); \
        asm volatile("s_waitcnt lgkmcnt(0)" ::: "memory"); SBAR();   \
        o[d0] = __builtin_amdgcn_mfma_f32_32x32x16_bf16(pa0, (bf16x8){l0[0], l0[1], l0[2], l0[3], h0[0], h0[1], h0[2], h0[3]}, o[d0], 0, 0, 0);   \
        o[d0] = __builtin_amdgcn_mfma_f32_32x32x16_bf16(pa1, (bf16x8){l1[0], l1[1], l1[2], l1[3], h1[0], h1[1], h1[2], h1[3]}, o[d0], 0, 0, 0);   \
        o[d0] = __builtin_amdgcn_mfma_f32_32x32x16_bf16(pa2, (bf16x8){l2[0], l2[1], l2[2], l2[3], h2[0], h2[1], h2[2], h2[3]}, o[d0], 0, 0, 0);   \
        o[d0] = __builtin_amdgcn_mfma_f32_32x32x16_bf16(pa3, (bf16x8){l3[0], l3[1], l3[2], l3[3], h3[0], h3[1], h3[2], h3[3]}, o[d0], 0, 0, 0); } while (0)
    PV_D0(0); PV_D0(1); PV_D0(2); PV_D0(3);
#undef PV_D0
#undef TRRD
}
__device__ __forceinline__ void attn_unit(LAS char* lds, int b, int h, int qb, const bf16* Qg, const bf16* Kg, const bf16* Vg, bf16* Og, const float* kmean, const float* tbh) {
    int tid_ = threadIdx.x; asm volatile("" : "+v"(tid_));
    const int tid = tid_, wid = __builtin_amdgcn_readfirstlane(tid >> 6), lane = tid & 63, r32 = lane & 31, hi = lane >> 5;
    LAS char* V_lds = lds + L_V; LAS char* K_lds = lds + L_K;
    LAS float* wsf = (LAS float*)(lds + L_WS) + wid * 64; LAS float* li_l = wsf; LAS float* al_l = wsf + 32;
    LAS float* KM = (LAS float*)(lds + L_KM); LAS int* SEL = (LAS int*)(lds + L_SEL); LAS float* TB = (LAS float*)(lds + L_TB);
    const size_t rowbase = (size_t)b * SEQ;
    __syncthreads();
    bf16x8 qr[8];
    { const bf16* qp = Qg + (rowbase + (size_t)qb * MBLK + wid * 32 + r32) * PITCH + h * HD + hi * 8;
#pragma unroll
      for (int d0 = 0; d0 < 8; ++d0) qr[d0] = *(const bf16x8*)(qp + d0 * 16); }
    const int sr = tid >> 4, sc8 = (tid & 15) * 8, vst0 = v_st(sr, sc8), vst1 = v_st(32 + sr, sc8), kws = KSWZ(sr, sc8 * 2);
    const bf16* Kh = Kg + rowbase * PITCH + h * HD + sc8; const bf16* Vh = Vg + rowbase * PITCH + h * HD + sc8;
    bf16x8 st_k0, st_k1, st_v0, st_v1;
#define ATT_LOAD(kb) do { st_k0 = *(const bf16x8*)(Kh + (size_t)((kb) + sr) * PITCH); st_k1 = *(const bf16x8*)(Kh + (size_t)((kb) + 32 + sr) * PITCH); \
                          st_v0 = *(const bf16x8*)(Vh + (size_t)((kb) + sr) * PITCH); st_v1 = *(const bf16x8*)(Vh + (size_t)((kb) + 32 + sr) * PITCH); } while (0)
#define ATT_WRITE(bf) do { *(LAS bf16x8*)(K_lds + (bf) * SHM_K + kws) = st_k0; *(LAS bf16x8*)(K_lds + (bf) * SHM_K + kws + 32 * 256) = st_k1; \
                           *(LAS bf16x8*)(V_lds + (bf) * SHM_V + vst0) = st_v0; *(LAS bf16x8*)(V_lds + (bf) * SHM_V + vst1) = st_v1; } while (0)
    ATT_LOAD(0);
    if (tid < 256) { const float* kp = kmean + (size_t)((b * NH + h) * NBLK + (tid >> 5)) * 256 + (tid & 31) * 4;
        *(LAS f32x4*)(KM + tid * 4) = (*(const f32x4*)kp + *(const f32x4*)(kp + 128)) * (1.0f / MBLK); }
    else if (tid < 256 + 129) TB[tid - 256] = tbh[tid - 256];
    __syncthreads();
    {
        const int row = tid >> 1, part = tid & 1;
        const bf16* qp = Qg + (rowbase + (size_t)qb * MBLK + row) * PITCH + h * HD;
        float a4[4] = {0.f, 0.f, 0.f, 0.f};
        if (qb > 3)
#pragma unroll 4
        for (int c = 0; c < 16; ++c) { const v4u qv = *(const v4u*)(qp + c * 8);
            const float q0 = __uint_as_float(qv.x << 16), q1 = __uint_as_float(qv.x & 0xffff0000u), q2 = __uint_as_float(qv.y << 16), q3 = __uint_as_float(qv.y & 0xffff0000u),
                        q4 = __uint_as_float(qv.z << 16), q5 = __uint_as_float(qv.z & 0xffff0000u), q6 = __uint_as_float(qv.w << 16), q7 = __uint_as_float(qv.w & 0xffff0000u);
#pragma unroll
            for (int nn = 0; nn < 4; ++nn) { const LAS float* km = KM + (2 * nn + part) * HD + c * 8; const f32x4 k0 = *(const LAS f32x4*)km, k1 = *(const LAS f32x4*)(km + 4);
                a4[nn] += (q0 * k0[0] + q1 * k0[1]) + (q2 * k0[2] + q3 * k0[3]) + (q4 * k1[0] + q5 * k1[1]) + (q6 * k1[2] + q7 * k1[3]); } }
        float sc[8];
#pragma unroll
        for (int nn = 0; nn < 4; ++nn) { const float ot = __shfl_xor(a4[nn], 1); sc[2 * nn] = part ? ot : a4[nn]; sc[2 * nn + 1] = part ? a4[nn] : ot; }
        int mask = 0;
        if (qb <= 3) mask = (1 << qb) - 1;
        else {
#pragma unroll
            for (int rd = 0; rd < 3; ++rd) { float best = -__builtin_inff(); int bi = 0;
#pragma unroll
                for (int n = 0; n < 8; ++n) { const bool ok = (n < qb) && !((mask >> n) & 1) && (sc[n] > best); best = ok ? sc[n] : best; bi = ok ? n : bi; }
                mask |= 1 << bi; } }
        if (part == 0) SEL[row] = mask;
    }
    ATT_WRITE(0);
    __syncthreads();
    const int selmask = SEL[wid * 32 + r32];
    if (wid >= 4) __builtin_amdgcn_s_setprio(1);
    const int qlo = qb * MBLK + wid * 32, qpos = qlo + r32;
    const int vbase = (int)(uintptr_t)(V_lds) + v_rd_base(lane);
    float m_reg = -1e30f, l_reg = 0.f; f32x16 o[4] = {};
    const int T = 4 * (qb + 1);
    const float NEG = -__builtin_inff();
    f32x16 pA0, pA1, pB0, pB1; float mnA, mnB, alA, alB; bf16x8 pa0, pa1, pa2, pa3;
#define ATT_ACT(t) ((((t) >> 2) == qb) ? ((t) * 64 <= qlo + 31) : (__any((selmask >> ((t) >> 2)) & 1) != 0))
#define ATT_QKT(P0_, P1_, t, KB) do { if (ATT_ACT(t)) qkt(P0_, P1_, K_lds + (KB) * SHM_K, r32, hi, qr); else { _Pragma("unroll") for (int r = 0; r < 16; ++r) { P0_[r] = NEG; P1_[r] = NEG; } } } while (0)
#define ATT_PV(t, VB) do { if (ATT_ACT(t)) pv_tile(o, vbase + (VB) * SHM_V, pa0, pa1, pa2, pa3); } while (0)
#define ATT_MASK(P0_, P1_, t) do { const int n_ = (t) >> 2, kb_ = (t) * 64; if (ATT_ACT(t)) { const bool rowsel = (n_ == qb) || ((selmask >> n_) & 1);                    \
        if (qlo - kb_ - 63 < 128) { const int dq = qpos - kb_ - 4 * hi;                                                                                          \
            _Pragma("unroll") for (int r = 0; r < 16; ++r) { const int c = (r & 3) + 8 * (r >> 2); const int rel0 = dq - c, rel1 = rel0 - 32;                      \
                const int i0 = rel0 < 0 ? 0 : (rel0 > 128 ? 128 : rel0), i1 = rel1 < 0 ? 0 : (rel1 > 128 ? 128 : rel1);                                         \
                const float v0 = P0_[r] + TB[i0], v1 = P1_[r] + TB[i1];                                                                                           \
                P0_[r] = (rowsel && rel0 >= 0) ? v0 : NEG; P1_[r] = (rowsel && rel1 >= 0) ? v1 : NEG;                                                             \
                if ((r & 3) == 3) asm volatile("" ::: "memory"); }                                                                                                \
        } else { _Pragma("unroll") for (int r = 0; r < 16; ++r) { P0_[r] = rowsel ? P0_[r] : NEG; P1_[r] = rowsel ? P1_[r] : NEG; } } } } while (0)
#define ATT_RESC(a) do { if (__any((a) < 1.f)) { if (hi == 0) al_l[r32] = (a); asm volatile("s_waitcnt lgkmcnt(0)" ::: "memory");                                \
        _Pragma("unroll") for (int d_ = 0; d_ < 4; ++d_) _Pragma("unroll") for (int r = 0; r < 16; ++r) o[d_][r] *= al_l[crow(r, hi)]; } } while (0)
    ATT_LOAD(64);
    SBAR(); ATT_QKT(pA0, pA1, 0, 0);
    ATT_MASK(pA0, pA1, 0); partialSM(pA0, pA1, m_reg, mnA, alA);
    ATT_WRITE(1);
    __syncthreads();
#define ATT_HALF_STEP(PX0, PX1, mnX, alX, PY0, PY1, alY, t, KB, VB, SB) do {                                                          \
        SBAR(); ATT_QKT(PX0, PX1, t, KB);                                                                                              \
        finishSM(PY0, PY1, alY, l_reg, pa0, pa1, pa2, pa3); SBAR();                                                                    \
        ATT_LOAD(((t) + 1) * 64); SBAR();                                                                                             \
        ATT_PV((t) - 1, VB); ATT_MASK(PX0, PX1, t); partialSM(PX0, PX1, m_reg, mnX, alX);                                              \
        __syncthreads();                                                                                                               \
        ATT_WRITE(SB);                                                                                                                 \
        ATT_RESC(alX); __syncthreads(); } while (0)
    for (int t = 1; t + 1 < T; t += 2) {
        ATT_HALF_STEP(pB0, pB1, mnB, alB, pA0, pA1, alA, t, 1, 0, 0);
        ATT_HALF_STEP(pA0, pA1, mnA, alA, pB0, pB1, alB, t + 1, 0, 1, 1);
    }
    SBAR(); ATT_QKT(pB0, pB1, T - 1, 1); SBAR();
    finishSM(pA0, pA1, alA, l_reg, pa0, pa1, pa2, pa3); SBAR();
    ATT_PV(T - 2, 0);
    ATT_MASK(pB0, pB1, T - 1); partialSM(pB0, pB1, m_reg, mnB, alB); ATT_RESC(alB);
    finishSM(pB0, pB1, alB, l_reg, pa0, pa1, pa2, pa3); SBAR(); ATT_PV(T - 1, 1);
#undef ATT_HALF_STEP
#undef ATT_RESC
#undef ATT_MASK
#undef ATT_PV
#undef ATT_QKT
#undef ATT_ACT
#undef ATT_LOAD
#undef ATT_WRITE
    __builtin_amdgcn_s_setprio(0);
    if (hi == 0) li_l[r32] = l_reg; asm volatile("s_waitcnt lgkmcnt(0)" ::: "memory");
    bf16* Ow = Og + (rowbase + (size_t)qb * MBLK + wid * 32) * PITCH + h * HD;
#pragma unroll
    for (int r = 0; r < 16; ++r) { const int orow = crow(r, hi); const float rl = __builtin_amdgcn_rcpf(li_l[orow]);
#pragma unroll
        for (int d0 = 0; d0 < 4; ++d0) { const float v = o[d0][r] * rl; const float vn = __shfl_xor(v, 1);
            if ((r32 & 1) == 0) *(unsigned*)(Ow + (size_t)orow * PITCH + d0 * 32 + r32) = cvtpk(v, vn); } }
}
#undef KSWZ
#undef SBAR
}
namespace hg {
using att::f32x16; using att::s16x4; using att::crow; using att::cvtpk;
constexpr int SET_BYTES = 49152, H_KD = 0, H_QD = 16384, H_IV = 32768, H_OB = 2 * SET_BYTES, OB_BYTES = 16384;
static_assert(H_OB + 2 * OB_BYTES <= RING_BYTES, "HGRN LDS map");
#define HG_KSWZ(row, colB) ((row) * 256 + ((colB) ^ (((row) & 7) << 4)))
typedef unsigned u32x2v __attribute__((ext_vector_type(2)));
typedef float f32x2v __attribute__((ext_vector_type(2)));
#define HG_TRRD(dst, base, off) asm volatile("ds_read_b64_tr_b16 %0, %1 offset:%2" : "=&v"(dst) : "v"(base), "i"(off) : "memory")
#define HG_MFMA(a, b, c) __builtin_amdgcn_mfma_f32_32x32x16_bf16(a, b, c, 0, 0, 0)
#define HG_BF8(l, h) ((bf16x8){l[0], l[1], l[2], l[3], h[0], h[1], h[2], h[3]})
#define HG_IBAR() do { asm volatile("s_waitcnt lgkmcnt(0)" ::: "memory"); __builtin_amdgcn_s_barrier(); asm volatile("" ::: "memory"); } while (0)

template <int TH>
__device__ __forceinline__ void m_half(const LAS char* KD, const LAS char* QD, LAS char* OBt, const f32x16 (&S)[4], bf16x8 B0, bf16x8 B1, bf16x8 B2, bf16x8 B3, int vt, int r32, int hi) {
    const int trow = TH * 32 + r32;
    bf16x8 qr[8];
#pragma unroll
    for (int d0 = 0; d0 < 8; ++d0) qr[d0] = *(const LAS bf16x8*)(QD + HG_KSWZ(trow, (d0 * 16 + hi * 8) * 2));
    f32x16 p0 = {}, p1 = {};
    { const LAS char* kb[4];
#pragma unroll
      for (int dd = 0; dd < 4; ++dd) kb[dd] = KD + HG_KSWZ(r32, (dd * 16 + hi * 8) * 2);
#pragma unroll
      for (int d0 = 0; d0 < 8; ++d0) { const LAS char* a = kb[d0 & 3] + (d0 >> 2) * 128;
          p0 = HG_MFMA(*reinterpret_cast<const LAS bf16x8*>(a), qr[d0], p0);
          if (TH == 1) p1 = HG_MFMA(*reinterpret_cast<const LAS bf16x8*>(a + 32 * 256), qr[d0], p1); } }
#pragma unroll
    for (int r = 0; r < 16; ++r) { const int s0 = crow(r, hi); p0[r] = (s0 <= trow) ? p0[r] : 0.f; if (TH == 1) p1[r] = (s0 + 32 <= trow) ? p1[r] : 0.f; }
    bf16x8 pa0, pa1, pa2, pa3; att::pack_p(p0, p1, pa0, pa1, pa2, pa3);
    f32x16 o = {};
    o = HG_MFMA(pa0, B0, o); o = HG_MFMA(pa1, B1, o);
    if (TH == 1) { o = HG_MFMA(pa2, B2, o); o = HG_MFMA(pa3, B3, o); }
#pragma unroll
    for (int hb = 0; hb < 2; ++hb) {
        u32x2v a0[4], a1[4];
#pragma unroll
        for (int i = 0; i < 4; ++i) { const int ix = hb * 4 + i, dt = ix >> 1, s2 = ix & 1, cb = (dt * 32 + 16 * s2 + 4 * hi) * 2;
            a0[i] = *(const LAS u32x2v*)(QD + HG_KSWZ(trow, cb)); a1[i] = *(const LAS u32x2v*)(QD + HG_KSWZ(trow, cb + 16)); }
        __builtin_amdgcn_sched_barrier(0);
#pragma unroll
        for (int i = 0; i < 4; ++i) { const int ix = hb * 4 + i, dt = ix >> 1, s2 = ix & 1;
            v4u aw = {a0[i].x, a0[i].y, a1[i].x, a1[i].y}; v4u bw = {cvtpk(S[dt][8 * s2 + 0], S[dt][8 * s2 + 1]), cvtpk(S[dt][8 * s2 + 2], S[dt][8 * s2 + 3]), cvtpk(S[dt][8 * s2 + 4], S[dt][8 * s2 + 5]), cvtpk(S[dt][8 * s2 + 6], S[dt][8 * s2 + 7])};
            o = HG_MFMA(*reinterpret_cast<bf16x8*>(&aw), *reinterpret_cast<bf16x8*>(&bw), o); }
    }
#pragma unroll
    for (int r = 0; r < 16; ++r) { const float v = o[r], vn = dpp_xor1(v);
        if ((r32 & 1) == 0) *(LAS unsigned*)(OBt + (TH * 32 + crow(r, hi)) * 256 + (vt * 32 + r32) * 2) = cvtpk(v, vn); }
}
__device__ __forceinline__ void hgrn_unit(LAS char* lds, LAS float* CLb  , int b, int h, const bf16* KDg, const float* CLg, const bf16* QBg, const bf16* IBg, const bf16* SGg, bf16* YB, const float* gain) {
    int tid_ = threadIdx.x; asm volatile("" : "+v"(tid_));
    const int tid = tid_, wid = __builtin_amdgcn_readfirstlane(tid >> 6), lane = tid & 63, r32 = lane & 31, hi = lane >> 5;
    const size_t rowbase = (size_t)b * SEQ; const int colh = h * HD;
    const size_t hbase = (size_t)h * SEQ * HD;
    constexpr int NCH = SEQ / 64;
    __syncthreads();
    if (wid < 4) {
        __builtin_amdgcn_s_setprio(1);
        const int vt = wid;
        f32x16 S[4] = {};
        const int g = lane >> 4, q4 = (lane >> 2) & 3, p4 = lane & 3;
        const int kdT = (8 * hi + q4) * 256 + ((32 * (g & 1) + 8 * p4) ^ (16 * q4));
        const int vrd = att::v_rd_base(lane) + vt * 512;
        __syncthreads();
        for (int n = 0; n < NCH; ++n) {
            const LAS char* setp = lds + (n & 1) * SET_BYTES; const LAS char* KD = setp + H_KD; const LAS char* QD = setp + H_QD;
            LAS char* OBt = lds + H_OB + (n & 1) * OB_BYTES; const LAS float* CL = CLb + (n & 1) * 128;
            const int vb = (int)(uintptr_t)(setp + H_IV) + vrd;
            s16x4 l0, l1, l2, l3, h0, h1, h2, h3;
            HG_TRRD(l0, vb, 0); HG_TRRD(h0, vb, 2048); HG_TRRD(l1, vb, 4096); HG_TRRD(h1, vb, 6144); HG_TRRD(l2, vb, 8192); HG_TRRD(h2, vb, 10240); HG_TRRD(l3, vb, 12288); HG_TRRD(h3, vb, 14336);
            asm volatile("s_waitcnt lgkmcnt(0)" ::: "memory"); __builtin_amdgcn_sched_barrier(0);
            const bf16x8 B0 = HG_BF8(l0, h0), B1 = HG_BF8(l1, h1), B2 = HG_BF8(l2, h2), B3 = HG_BF8(l3, h3);
            m_half<0>(KD, QD, OBt, S, B0, B1, B2, B3, vt, r32, hi);
            m_half<1>(KD, QD, OBt, S, B0, B1, B2, B3, vt, r32, hi);
            const int kb = (int)(uintptr_t)KD + kdT;
            s16x4 ka[2][8];
#define HG_KOFF(dt, ks, hf) ((ks) * 4096 + (hf) * 1024 + (((dt) * 64) ^ ((hf) * 64)))
#define HG_KRD(dt, b_) do { HG_TRRD(ka[b_][0], kb, HG_KOFF(dt, 0, 0)); HG_TRRD(ka[b_][1], kb, HG_KOFF(dt, 0, 1)); HG_TRRD(ka[b_][2], kb, HG_KOFF(dt, 1, 0)); HG_TRRD(ka[b_][3], kb, HG_KOFF(dt, 1, 1)); \
                HG_TRRD(ka[b_][4], kb, HG_KOFF(dt, 2, 0)); HG_TRRD(ka[b_][5], kb, HG_KOFF(dt, 2, 1)); HG_TRRD(ka[b_][6], kb, HG_KOFF(dt, 3, 0)); HG_TRRD(ka[b_][7], kb, HG_KOFF(dt, 3, 1)); } while (0)
#define HG_KMM(dt, b_) do { S[dt] = HG_MFMA(HG_BF8(ka[b_][0], ka[b_][1]), B0, S[dt]); S[dt] = HG_MFMA(HG_BF8(ka[b_][2], ka[b_][3]), B1, S[dt]); S[dt] = HG_MFMA(HG_BF8(ka[b_][4], ka[b_][5]), B2, S[dt]); S[dt] = HG_MFMA(HG_BF8(ka[b_][6], ka[b_][7]), B3, S[dt]); } while (0)
            HG_KRD(0, 0);
            asm volatile("s_waitcnt lgkmcnt(0)" ::: "memory"); __builtin_amdgcn_sched_barrier(0);
            HG_KRD(1, 1); HG_KMM(0, 0);
            asm volatile("s_waitcnt lgkmcnt(0)" ::: "memory"); __builtin_amdgcn_sched_barrier(0);
            HG_KRD(2, 0); HG_KMM(1, 1);
            asm volatile("s_waitcnt lgkmcnt(0)" ::: "memory"); __builtin_amdgcn_sched_barrier(0);
            HG_KRD(3, 1); HG_KMM(2, 0);
            asm volatile("s_waitcnt lgkmcnt(0)" ::: "memory"); __builtin_amdgcn_sched_barrier(0);
            HG_KMM(3, 1);
#undef HG_KMM
#undef HG_KRD
#undef HG_KOFF
#pragma unroll
            for (int dt = 0; dt < 4; ++dt)
#pragma unroll
                for (int gg = 0; gg < 4; ++gg) { const f32x4 c4 = *(const LAS f32x4*)(CL + dt * 32 + 8 * gg + 4 * hi);
#pragma unroll
                    for (int j = 0; j < 4; ++j) S[dt][4 * gg + j] *= c4[j]; }
            HG_IBAR();
        }
        HG_IBAR();
        __builtin_amdgcn_s_setprio(0);
    } else {
        const int ew = wid - 4, te = tid - 256;
        const int g8 = lane >> 3, cq = lane & 7, dch = 32 * ew + 4 * cq;
        const int isr = te >> 4, isc = (te & 15) * 8;
        const int nrow = te >> 2, npart = te & 3;
        u32x2v kdraw[8], qraw[8]; bf16x8 iraw[4]; v4u sgraw[4]; f32x4 clraw = {1.f, 1.f, 1.f, 1.f};
#define HG_LOAD(n) do { _Pragma("unroll") for (int tt = 0; tt < 8; ++tt) { const size_t gi = hbase + (rowbase + (n) * 64 + g8 + 8 * tt) * HD + dch; kdraw[tt] = __builtin_nontemporal_load((const u32x2v*)(KDg + gi)); qraw[tt] = __builtin_nontemporal_load((const u32x2v*)(QBg + gi)); } \
        if (g8 == 0) clraw = __builtin_nontemporal_load((const f32x4*)(CLg + ((size_t)b * NCH + (n)) * AW + colh + dch)); \
        _Pragma("unroll") for (int k = 0; k < 4; ++k) iraw[k] = __builtin_nontemporal_load((const bf16x8*)(IBg + hbase + (rowbase + (n) * 64 + isr + 16 * k) * HD + isc)); } while (0)
#define HG_LOADSG(n) do { _Pragma("unroll") for (int k = 0; k < 4; ++k) sgraw[k] = __builtin_nontemporal_load((const v4u*)(SGg + hbase + (rowbase + (n) * 64 + nrow) * HD + 32 * npart + 8 * k)); } while (0)
#define HG_ESTAGE(n) do { LAS char* setp = lds + ((n) & 1) * SET_BYTES; LAS char* KD = setp + H_KD; LAS char* QD = setp + H_QD; LAS char* IV = setp + H_IV;                         \
            _Pragma("unroll") for (int tt = 0; tt < 8; ++tt) { const int t = g8 + 8 * tt, a = HG_KSWZ(t, dch * 2); *(LAS u32x2v*)(QD + a) = qraw[tt]; *(LAS u32x2v*)(KD + a) = kdraw[tt]; }                      \
            if (g8 == 0) *(LAS f32x4*)(CLb + ((n) & 1) * 128 + dch) = clraw;                                                                                                          \
            _Pragma("unroll") for (int k = 0; k < 4; ++k) *(LAS bf16x8*)(IV + att::v_st(isr + 16 * k, isc)) = iraw[k]; } while (0)
        HG_LOAD(0); HG_ESTAGE(0); HG_LOAD(1); HG_LOADSG(0);
        __syncthreads();
        for (int n = 0; n <= NCH; ++n) {
            if (n >= 1) { const int m = n - 1; const LAS char* OBt = lds + H_OB + (m & 1) * OB_BYTES + nrow * 256 + npart * 64;
                float ov[32]; float ss = 0.f;
#pragma unroll
                for (int k = 0; k < 4; ++k) { const v4u w = *(const LAS v4u*)(OBt + 16 * k);
                    ov[8 * k + 0] = __uint_as_float(w.x << 16); ov[8 * k + 1] = __uint_as_float(w.x & 0xffff0000u); ov[8 * k + 2] = __uint_as_float(w.y << 16); ov[8 * k + 3] = __uint_as_float(w.y & 0xffff0000u);
                    ov[8 * k + 4] = __uint_as_float(w.z << 16); ov[8 * k + 5] = __uint_as_float(w.z & 0xffff0000u); ov[8 * k + 6] = __uint_as_float(w.w << 16); ov[8 * k + 7] = __uint_as_float(w.w & 0xffff0000u); }
#pragma unroll
                for (int j = 0; j < 32; ++j) ss = fmaf(ov[j], ov[j], ss);
                ss += dpp_xor1(ss); ss += dpp_xor2(ss);
                const float rstd = 1.0f / sqrtf(ss * (1.0f / HD) + NORM_EPS);
                bf16* yp = YB + (rowbase + m * 64 + nrow) * AW + colh + 32 * npart; const float* gp = gain + colh + 32 * npart;
#pragma unroll
                for (int k = 0; k < 4; ++k) { const f32x4 g0 = *(const f32x4*)(gp + 8 * k), g1 = *(const f32x4*)(gp + 8 * k + 4); const v4u sw = sgraw[k];
                    v4u yw;
                    yw.x = cvtpk(ov[8 * k + 0] * rstd * g0[0] * __uint_as_float(sw.x << 16), ov[8 * k + 1] * rstd * g0[1] * __uint_as_float(sw.x & 0xffff0000u));
                    yw.y = cvtpk(ov[8 * k + 2] * rstd * g0[2] * __uint_as_float(sw.y << 16), ov[8 * k + 3] * rstd * g0[3] * __uint_as_float(sw.y & 0xffff0000u));
                    yw.z = cvtpk(ov[8 * k + 4] * rstd * g1[0] * __uint_as_float(sw.z << 16), ov[8 * k + 5] * rstd * g1[1] * __uint_as_float(sw.z & 0xffff0000u));
                    yw.w = cvtpk(ov[8 * k + 6] * rstd * g1[2] * __uint_as_float(sw.w << 16), ov[8 * k + 7] * rstd * g1[3] * __uint_as_float(sw.w & 0xffff0000u));
                    *(v4u*)(yp + 8 * k) = yw; } }
            if (n < NCH) HG_LOADSG(n);
            if (n + 1 < NCH) { HG_ESTAGE(n + 1); if (n + 2 < NCH) HG_LOAD(n + 2); }
            HG_IBAR();
        }
#undef HG_ESTAGE
#undef HG_LOADSG
#undef HG_LOAD
    }
}
#undef HG_IBAR
#undef HG_BF8
#undef HG_MFMA
#undef HG_TRRD
#undef HG_KSWZ
}
#define PH_IDS() int tid_ = threadIdx.x; asm volatile("" : "+v"(tid_)); const int tid = tid_, lane = tid & 63, wave = __builtin_amdgcn_readfirstlane(tid >> 6); (void)lane; (void)wave
struct Frame {
    LAS unsigned char* lds;
    volatile LAS unsigned* MISC;
    gu32* ctl;
    int vcu, G;
    unsigned char* ws;
    const float* in[16];
    float* out;
};
__device__ const unsigned char k_t5b[128] = {0, 1, 2, 3, 4, 5, 6, 7, 8, 9, 10, 11, 12, 13, 14, 15, 16, 16, 16, 17, 17, 18, 18, 18, 19, 19, 19, 20, 20, 20, 20, 21, 21, 21, 21, 22, 22, 22, 22, 22, 23, 23, 23, 23, 23, 23,
    24, 24, 24, 24, 24, 24, 25, 25, 25, 25, 25, 25, 25, 26, 26, 26, 26, 26, 26, 26, 26, 27, 27, 27, 27, 27, 27, 27, 27, 27, 27, 28, 28, 28, 28, 28, 28, 28, 28, 28, 28, 29, 29, 29, 29, 29, 29, 29, 29, 29, 29, 29, 29,
    30, 30, 30, 30, 30, 30, 30, 30, 30, 30, 30, 30, 30, 30, 31, 31, 31, 31, 31, 31, 31, 31, 31, 31, 31, 31, 31, 31, 31};

__device__ __forceinline__ void p0_transpose_item(const float* W, int K, int N, bf16* WT, const float* gain, int mapmode, LAS float* scr, int item, int lane) {
    const int nblk = N / 32, kb = item / nblk, nb = item % nblk, k0 = 64 * kb, n0 = 32 * nb;
    const int kr = lane >> 3, nq = 4 * (lane & 7);
    f32x4 v[8];
#pragma unroll
    for (int i = 0; i < 8; ++i) v[i] = __builtin_nontemporal_load((const GAS f32x4*)(W + (size_t)(k0 + 8 * i + kr) * N + n0 + nq));
    if (gain) {
#pragma unroll
        for (int i = 0; i < 8; ++i) v[i] = v[i] * gain[k0 + 8 * i + kr]; }
#pragma unroll
    for (int i = 0; i < 8; ++i) { LAS float* s = scr + (8 * i + kr) * 33 + nq; s[0] = v[i].x; s[1] = v[i].y; s[2] = v[i].z; s[3] = v[i].w; }
    LDS_WAIT(); asm volatile("" ::: "memory");
    int r0 = n0;
    if (mapmode == 1) { const int j = n0 < DFF ? n0 : n0 - DFF; r0 = 256 * (j >> 7) + (j & 127) + (n0 < DFF ? 0 : 128); }
    if (mapmode == 2 && n0 >= 3 * AW && n0 < 5 * AW) { const int j = (n0 - 3 * AW) & (AW - 1); r0 = 3 * AW + 256 * (j >> 7) + (j & 127) + (n0 < 4 * AW ? 0 : 128); }
    if (mapmode == 2 && n0 >= 7 * AW) { const int j = n0 - 7 * AW, jj = j & (2 * AW - 1); r0 = 7 * AW + 256 * (jj >> 7) + (jj & 127) + (j < 2 * AW ? 0 : 128); }
    const int c = lane & 7;
#pragma unroll
    for (int j = 0; j < 4; ++j) { const int n = (lane >> 3) + 8 * j; const LAS float* s = scr + (8 * c) * 33 + n;
        v4u o; o.x = pk2(s[0 * 33], s[1 * 33]); o.y = pk2(s[2 * 33], s[3 * 33]); o.z = pk2(s[4 * 33], s[5 * 33]); o.w = pk2(s[6 * 33], s[7 * 33]);
        *(GAS v4u*)(WT + (size_t)(r0 + n) * K + k0 + 8 * c) = o; }
    LDS_WAIT(); asm volatile("" ::: "memory");
}
constexpr int I_IN = (DM / 64) * (INW / 32), I_GU = (DM / 64) * (2 * DFF / 32), I_DN = (DFF / 64) * (DM / 32), I_SQ = (DM / 64) * (DM / 32), I_AB = (AW / 64) * (DM / 32), I_PLE = (PLED / 64) * (DM / 32);
constexpr int I_LATE = I_GU + I_DN + 2 * I_SQ + 2 * I_AB + I_PLE;
__device__ __forceinline__ void p0_late_item(Frame& F, LAS float* scr, int r, int lane) {
    bf16* Wgu_t = (bf16*)(F.ws + WS_WGU); bf16* Wdn_t = (bf16*)(F.ws + WS_WDN); bf16* Wout_t = (bf16*)(F.ws + WS_WOUT);
    bf16* Wpg_t = (bf16*)(F.ws + WS_WPG); bf16* Wa_t = (bf16*)(F.ws + WS_WA); bf16* Wb_t = (bf16*)(F.ws + WS_WB); bf16* Wple_t = (bf16*)(F.ws + WS_WPLE);
    if (r < I_GU) { p0_transpose_item(F.in[9], DM, 2 * DFF, Wgu_t, F.in[8], 1, scr, r, lane); return; } r -= I_GU;
    if (r < I_DN) { p0_transpose_item(F.in[10], DFF, DM, Wdn_t, nullptr, 0, scr, r, lane); return; } r -= I_DN;
    if (r < I_SQ) { p0_transpose_item(F.in[7], DM, DM, Wout_t, nullptr, 0, scr, r, lane); return; } r -= I_SQ;
    if (r < I_SQ) { p0_transpose_item(F.in[12], DM, DM, Wpg_t, nullptr, 0, scr, r, lane); return; } r -= I_SQ;
    if (r < I_AB) { p0_transpose_item(F.in[5], AW, DM, Wa_t, nullptr, 0, scr, r, lane); return; } r -= I_AB;
    if (r < I_AB) { p0_transpose_item(F.in[6], AW, DM, Wb_t, nullptr, 0, scr, r, lane); return; } r -= I_AB;
    p0_transpose_item(F.in[11], PLED, DM, Wple_t, nullptr, 0, scr, r, lane);
}
__device__ __forceinline__ void p0_filler(Frame& F, int part) {
    PH_IDS();
    LAS float* scr = (LAS float*)(F.lds + RING_OFF + wave * 16384);
    const int gw = F.vcu * NWAVES + wave, NGW = F.G * NWAVES;
    const int nw = (I_LATE - gw + NGW - 1) / NGW, cut = (nw * (int)(blockIdx.x & 7) + 3) / 7;
    const int j0 = part == 0 ? 0 : cut, j1 = part == 0 ? cut : nw;
#pragma nounroll
    for (int j = j0; j < j1; ++j) p0_late_item(F, scr, gw + j * NGW, lane);
}
__device__ __forceinline__ void p0_pconv(Frame& F) {
    PH_IDS();
    const int gw = F.vcu * NWAVES + wave, NGW = F.G * NWAVES;
    { bf16* PB = (bf16*)(F.ws + WS_PB); const GAS f32x4* p4 = (const GAS f32x4*)F.in[1]; GAS unsigned long long* o8 = (GAS unsigned long long*)PB;
      const int gt = gw * 64 + lane, NGT = NGW * 64;
      for (int i = gt; i < M * PLED / 4; i += NGT) { const f32x4 v = __builtin_nontemporal_load(p4 + i); o8[i] = (unsigned long long)pk2(v.x, v.y) | ((unsigned long long)pk2(v.z, v.w) << 32); } }
}
__device__ __forceinline__ void p0_prologue(Frame& F) {
    PH_IDS();
    LAS float* scr = (LAS float*)(F.lds + RING_OFF + wave * 16384);
    const int gw = F.vcu * NWAVES + wave, NGW = F.G * NWAVES;
    bf16* Win_t = (bf16*)(F.ws + WS_WIN);
#define P0_TRANSPOSES() do { \
    for (int it = gw; it < I_IN; it += NGW) p0_transpose_item(F.in[3], DM, INW, Win_t, F.in[2], 2, scr, it, lane); \
    } while (0)
    const bool xfirst = (wave & 1) != 0;
    if (!xfirst) P0_TRANSPOSES();
    { bf16* XB = (bf16*)(F.ws + WS_RA); float* rstd0 = (float*)(F.ws + WS_RSTD0); const float* x = F.in[0];
      for (int m = gw; m < M; m += NGW) { const GAS f32x4* xr = (const GAS f32x4*)(x + (size_t)m * DM) + lane; f32x4 v[8]; float s = 0.f;
#pragma unroll
          for (int j = 0; j < 8; ++j) { v[j] = __builtin_nontemporal_load(xr + 64 * j); s += (v[j].x * v[j].x + v[j].y * v[j].y) + (v[j].z * v[j].z + v[j].w * v[j].w); }
          s = wave_sum(s); if (lane == 0) rstd0[m] = 1.0f / sqrtf(s * (1.0f / DM) + NORM_EPS);
          GAS unsigned long long* o8 = (GAS unsigned long long*)(XB + (size_t)m * DM) + lane;
#pragma unroll
          for (int j = 0; j < 8; ++j) o8[64 * j] = (unsigned long long)pk2(v[j].x, v[j].y) | ((unsigned long long)pk2(v[j].z, v[j].w) << 32); } }
    if (xfirst) P0_TRANSPOSES();
#undef P0_TRANSPOSES
    if (blockIdx.x == 0) { float* lb = (float*)(F.ws + WS_LB); const float* lg = F.in[14];
        for (int d = tid; d < AW; d += NWAVES * 64) lb[d] = 1.0f / (1.0f + expf(lg[AW + d] - lg[d])); }
    if (blockIdx.x == 1 || F.G == 1) { float* tb = (float*)(F.ws + WS_TB); const float* rb = F.in[13];
        for (int i = tid; i < NH * 129; i += NWAVES * 64) { const int h = i / 129, rel = i % 129; tb[i] = rel < 128 ? (rb[(int)k_t5b[rel] * NH + h] - rb[31 * NH + h]) * (1.0f / att::SCALE) : 0.f; } }
}
__device__ __forceinline__ void p9_final(Frame& F, const bf16* X3B) {
    PH_IDS();
    const float* ssp = (const float*)(F.ws + WS_SS3); const float* gain = F.in[15];
    f32x4 gv[8];
#pragma unroll
    for (int j = 0; j < 8; ++j) gv[j] = *((const GAS f32x4*)gain + lane + 64 * j);
    const int prow0 = (8 * (int)(blockIdx.x & 7) + (int)((blockIdx.x >> 3) & 7)) * 256 + (int)(blockIdx.x >> 6) * 64;
    float sk[8];
#pragma unroll
    for (int k = 0; k < 8; ++k) sk[k] = lane < 32 ? ssp[(size_t)(prow0 + wave + 8 * k) * 32 + lane] : 0.f;
#pragma unroll
    for (int o = 1; o < 64; o <<= 1)
#pragma unroll
        for (int k = 0; k < 8; ++k) sk[k] += __shfl_xor(sk[k], o);
#pragma unroll
    for (int k = 0; k < 8; ++k) sk[k] = 1.0f / sqrtf(sk[k] * (1.0f / DM) + NORM_EPS);
    unsigned long long w[8], wn[8];
    { const GAS unsigned long long* xi = (const GAS unsigned long long*)(X3B + (size_t)(prow0 + wave) * DM) + lane;
#pragma unroll
      for (int j = 0; j < 8; ++j) w[j] = __builtin_nontemporal_load(xi + 64 * j); }
#pragma unroll
    for (int k = 0; k < 8; ++k) { const int m = prow0 + wave + 8 * k; const float rstd = sk[k];
        if (k + 1 < 8) { const GAS unsigned long long* xi = (const GAS unsigned long long*)(X3B + (size_t)(m + 8) * DM) + lane;
#pragma unroll
            for (int j = 0; j < 8; ++j) wn[j] = __builtin_nontemporal_load(xi + 64 * j); }
        GAS f32x4* xr = (GAS f32x4*)(F.out + (size_t)m * DM) + lane;
#pragma unroll
        for (int j = 0; j < 8; ++j) { const unsigned lo = (unsigned)w[j], hi = (unsigned)(w[j] >> 32);
            f32x4 v = {__uint_as_float(lo << 16), __uint_as_float(lo & 0xffff0000u), __uint_as_float(hi << 16), __uint_as_float(hi & 0xffff0000u)};
            xr[64 * j] = v * rstd * gv[j]; }
#pragma unroll
        for (int j = 0; j < 8; ++j) w[j] = wn[j];
    }
}
__device__ __forceinline__ void build_rstd_tab(Frame& F, const float* ssp, int pm) {
    PH_IDS();
    LAS float* tab = (LAS float*)(F.lds + TAB_OFF);
    const int row = tid >> 1, hf = tid & 1; const GAS f32x4* p = (const GAS f32x4*)(ssp + (size_t)(pm * 256 + row) * 32 + hf * 16);
    const f32x4 a = p[0], b = p[1], c = p[2], d = p[3];
    float s = ((a.x + a.y) + (a.z + a.w)) + ((b.x + b.y) + (b.z + b.w)) + ((c.x + c.y) + (c.z + c.w)) + ((d.x + d.y) + (d.z + d.w));
    const float o = __shfl_xor(s, 1); s = hf ? o + s : s + o;
    if (hf == 0) tab[row] = 1.0f / sqrtf(s * (1.0f / DM) + NORM_EPS);
    __syncthreads();
}

__device__ __forceinline__ void build_rstd0_tab(Frame& F, const float* rstd0, int pm) {
    PH_IDS();
    LAS float* tab = (LAS float*)(F.lds + TAB_OFF);
    if (tid < 256) tab[tid] = rstd0[pm * 256 + tid];
    __syncthreads();
}
struct Args { const float* in[16]; float* out; unsigned char* ws; int ph_lo, ph_hi; };
__global__ void __launch_bounds__(NWAVES * 64, 2) mk_fwd(Args args) {
    extern __shared__ __attribute__((aligned(16))) unsigned char lds[];
    Frame F;
    F.lds = (LAS unsigned char*)lds;
    F.MISC = (volatile LAS unsigned*)(F.lds + MISC_OFF);
    F.G = gridDim.x; { const int bx = blockIdx.x; F.vcu = (F.G % 8 == 0) ? (bx % 8) * (F.G / 8) + bx / 8 : bx; }
    F.ws = args.ws; F.ctl = (gu32*)(args.ws + WS_CTL); F.out = args.out;
#pragma unroll
    for (int i = 0; i < 16; ++i) F.in[i] = args.in[i];
    for (int u = threadIdx.x; u < (LDS_BYTES - LDSCTL_OFF) / 4; u += NWAVES * 64) ((LAS unsigned*)(F.lds + LDSCTL_OFF))[u] = 0u;
    __syncthreads();
    XcdBarrier bar; bar.bar = (unsigned*)(F.ctl + CW_BAR); bar.x = 0; bar.st = nullptr;
    if (N_LAUNCHES == 1) bar = xcd_barrier_post((unsigned*)(F.ctl + CW_BAR), F.MISC + 8);
#define GRID_BAR() do { if (N_LAUNCHES == 1) xcd_barrier(bar); } while (0)
    GrpBar gbar; gbar.cnt = (unsigned*)(F.ctl + CW_GRP + 64 * (blockIdx.x & 7)); gbar.tgt = 0u; gbar.n = gridDim.x / 8; gbar.light = 0;
    if (N_LAUNCHES == 1 && threadIdx.x == 0) (void)__hip_atomic_fetch_or((unsigned*)(F.ctl + CW_GRPX + 64 * (blockIdx.x & 7)), 1u << bar.x, RLX_AGENT);
#define GRP_BAR() do { if (N_LAUNCHES == 1) grp_barrier(gbar, (unsigned*)(F.ctl + CW_BAR), nullptr); } while (0)
    GrpBar pbar; pbar.cnt = (unsigned*)(F.ctl + CW_PNL + 16 * (blockIdx.x & 63)); pbar.tgt = 0u; pbar.n = gridDim.x / 64; pbar.light = 0;
#define PNL_BAR() do { if (N_LAUNCHES == 1) grp_barrier(pbar, (unsigned*)(F.ctl + CW_BAR), nullptr); } while (0)
    const int lo = args.ph_lo, hi = args.ph_hi;
#ifndef PH_MASK
#define PH_MASK 0x3ff
#endif
#define IN(k) (((PH_MASK >> (k)) & 1) && lo <= (k) && (k) < hi)
#ifndef DUP_MASK
#define DUP_MASK 0
#endif
#define REP(k) for (int rep_ = 0; rep_ < 1 + ((DUP_MASK >> (k)) & 1); ++rep_)
    unsigned char* ws = args.ws;
    const int c = (int)blockIdx.x, bq = c & 7;
#define ARENA_PTR(off, rowbytes) (ws + WS_ARENA + (size_t)bq * (ARENA_STRIDE - (size_t)SEQ * (rowbytes)) + (off))
    bf16* XS = (bf16*)(ws + WS_RA); bf16* X3B = (bf16*)ARENA_PTR(AO_X3B, DM * 2);
    bf16* Qb = (bf16*)ARENA_PTR(AO_Q, AW * 2); bf16* Kb = (bf16*)ARENA_PTR(AO_K, AW * 2); bf16* Vb = (bf16*)ARENA_PTR(AO_V, AW * 2); bf16* QBb = (bf16*)ARENA_PTR(AO_QB, HD * 2); bf16* KDb = (bf16*)ARENA_PTR(AO_KD, HD * 2); float* CLg = (float*)(ws + WS_ARENA + (size_t)bq * (ARENA_STRIDE - (size_t)(SEQ / 64) * AW * 4) + AO_CL);
    bf16* IBb = (bf16*)ARENA_PTR(AO_IB, HD * 2); bf16* SGb = (bf16*)ARENA_PTR(AO_SG, HD * 2); bf16* YB = (bf16*)ARENA_PTR(AO_YB, AW * 2); bf16* YA = (bf16*)ARENA_PTR(AO_YA, AW * 2);
    bf16* GA = (bf16*)((unsigned char*)args.out + (size_t)bq * (8 * MiB)); bf16* GB = (bf16*)((unsigned char*)GA + 8 * MiB); bf16* MIX = GB;
    bf16* ACT = (bf16*)ARENA_PTR(AO_ACT, DFF * 2); bf16* PLEb = (bf16*)ARENA_PTR(AO_PLE, DM * 2); bf16* PB = (bf16*)(ws + WS_PB);
#undef ARENA_PTR

    if (IN(0)) { p0_prologue(F); GRID_BAR();
        if (N_LAUNCHES == 1) { const unsigned xm = xb_ld((unsigned*)(F.ctl + CW_GRPX + 64 * (blockIdx.x & 7))); gbar.light = __builtin_amdgcn_readfirstlane((xm & (xm - 1u)) == 0u ? 1 : 0); pbar.light = gbar.light; }
#if defined(PROBE_P0)
        p0_prologue(F); GRID_BAR();
#endif
    }
    if (IN(1)) REP(1) {
        p0_filler(F, 0); __syncthreads();
        pg8::Gemm g{XS, (const bf16*)(ws + WS_WIN), M, INW, DM}; pg8::StaticOrder S; S.init(M, INW, F.G, c);
        pg8::Unit u0; S.next(0, u0); build_rstd0_tab(F, (const float*)(ws + WS_RSTD0), u0.pm);
        pg8::EpiInProj E{Qb, Kb, Vb, QBb, IBb, SGb, GA, GB, KDb, CLg, (const PG8_LAS float*)(F.lds + TAB_OFF), (const float*)(ws + WS_LB), (float*)(ws + WS_KMEAN)};
        pg8::gemm_phase<pg8::EpiInProj, pg8::StaticOrder, PG8_ALIGN, PG8_SP2>(F.lds + RING_OFF, g, S, E);
        __syncthreads(); p0_filler(F, 1); p0_pconv(F);
        if (N_LAUNCHES == 1) grp_barrier(gbar, (unsigned*)(F.ctl + CW_BAR), (unsigned*)(F.ctl + CW_LATE));
#if defined(PROBE_KLOOP)
        { pg8::EpiNull E0;
#if PROBE_KLOOP == 2
          pg8::SameTileOrder S0; S0.n = 11; pg8::gemm_phase<pg8::EpiNull, pg8::SameTileOrder, PG8_ALIGN, PG8_SP2>(F.lds + RING_OFF, g, S0, E0);
#else
          pg8::gemm_phase<pg8::EpiNull, pg8::StaticOrder, PG8_ALIGN, PG8_SP2>(F.lds + RING_OFF, g, S, E0);
#endif
          GRID_BAR(); }
#endif
    }
    {
        const float* kmp = (const float*)(ws + WS_KMEAN); const float* tb = (const float*)(ws + WS_TB);
#define P2_BODY(do_h, do_a) do {                                                                                                                                                  \
        if (F.G == 256) {                                                                                                                                                       \
            const int xg = F.vcu >> 5, xi = F.vcu & 31;                                                                                                                         \
            if (xi < 8) { const int it = xg * 8 + xi; if (do_h) hg::hgrn_unit((LAS char*)(F.lds + RING_OFF), (LAS float*)(F.lds + TAB_OFF), it / NH, it % NH, KDb, CLg, QBb, IBb, SGb, YB, F.in[4]); } \
            else { const int a = xg * 24 + (xi - 8), bh = a / 3, grp = a - 3 * bh, b = bh / NH, h = bh % NH;                                                                    \
                const int list = grp == 0 ? 0x027 : (grp == 1 ? 0x46 : 0x135), cnt = grp == 1 ? 2 : 3;       \
                if (do_a) { _Pragma("nounroll") for (int i = 0; i < cnt; ++i) att::attn_unit((LAS char*)(F.lds + RING_OFF), b, h, (list >> (4 * i)) & 15, Qb, Kb, Vb, YA, kmp, tb + h * 129); } } \
        } else {                                                                                                                                                                \
            for (int it = F.vcu; it < BATCH * NH; it += F.G) hg::hgrn_unit((LAS char*)(F.lds + RING_OFF), (LAS float*)(F.lds + TAB_OFF), it / NH, it % NH, KDb, CLg, QBb, IBb, SGb, YB, F.in[4]);  \
            for (int v = F.vcu; v < BATCH * NH * NBLK; v += F.G) { const int bh = v >> 3; att::attn_unit((LAS char*)(F.lds + RING_OFF), bh / NH, bh % NH, 7 - (v & 7), Qb, Kb, Vb, YA, kmp, tb + (bh % NH) * 129); } \
        }                                                                                                                                                                       \
        GRP_BAR(); } while (0)
        if (IN(2)) { P2_BODY(true, true);
#if defined(PROBE_P2)
            P2_BODY((PROBE_P2 & 2) != 0, (PROBE_P2 & 1) != 0);
#endif
        }
#undef P2_BODY
    }
#if defined(PROBE_XBAR)
    GRID_BAR();
#endif
    if (IN(4)) REP(4) {
        if (N_LAUNCHES == 1) late_wait((unsigned*)(F.ctl + CW_LATE), gridDim.x, (unsigned*)(F.ctl + CW_BAR));
        pg8::Gemm g{YA, (const bf16*)(ws + WS_WA), M, DM, AW, YB, (const bf16*)(ws + WS_WB)}; pg8::StaticOrder S; S.init(M, DM, F.G, c); pg8::EpiMix2 E{MIX, GA, GB};
        pg8::gemm_phase<pg8::EpiMix2, pg8::StaticOrder, PG8_ALIGN, PG8_SP2, true>(F.lds + RING_OFF, g, S, E);
        PNL_BAR();
    }
    if (IN(5)) REP(5) {
        pg8::Gemm g{MIX, (const bf16*)(ws + WS_WOUT), M, DM, DM}; pg8::StaticOrder S; S.init(M, DM, F.G, c);
        pg8::EpiResid<true> E{XS, XS, (float*)(ws + WS_SS1)};
        pg8::gemm_phase<pg8::EpiResid<true>, pg8::StaticOrder, PG8_ALIGN, PG8_SP2>(F.lds + RING_OFF, g, S, E);
        PNL_BAR();
    }
    if (IN(6)) REP(6) {
        pg8::Gemm g{XS, (const bf16*)(ws + WS_WGU), M, 2 * DFF, DM}; pg8::StaticOrder S; S.init(M, 2 * DFF, F.G, c);
        pg8::Unit u0; S.next(0, u0); build_rstd_tab(F, (const float*)(ws + WS_SS1), u0.pm);
        pg8::EpiGateUp E{ACT, (const PG8_LAS float*)(F.lds + TAB_OFF), DFF};
        pg8::gemm_phase<pg8::EpiGateUp, pg8::StaticOrder, PG8_ALIGN, PG8_SP2>(F.lds + RING_OFF, g, S, E);
        PNL_BAR();
    }
    if (IN(7)) {
        pg8::Gemm g{ACT, (const bf16*)(ws + WS_WDN), M, DM, DFF}; pg8::StaticOrder S; S.init(M, DM, F.G, c);
        pg8::EpiResid<false> E{XS, XS, nullptr};
        pg8::gemm_phase<pg8::EpiResid<false>, pg8::StaticOrder, PG8_ALIGN, PG8_SP2>(F.lds + RING_OFF, g, S, E);
        GRP_BAR();
    }
    if (IN(8)) {
        { pg8::Gemm g{PB, (const bf16*)(ws + WS_WPLE), M, DM, PLED}; pg8::StaticOrder S; S.init(M, DM, F.G, c); pg8::EpiPle E{PLEb};
          pg8::gemm_phase<pg8::EpiPle, pg8::StaticOrder, PG8_ALIGN, PG8_SP2>(F.lds + RING_OFF, g, S, E); }
        VM_WAIT(); __syncthreads();
        { pg8::Gemm g{XS, (const bf16*)(ws + WS_WPG), M, DM, DM}; pg8::StaticOrder S; S.init(M, DM, F.G, c); pg8::EpiPleGate E{XS, X3B, PLEb, (float*)(ws + WS_SS3)};
          pg8::gemm_phase<pg8::EpiPleGate, pg8::StaticOrder, PG8_ALIGN, PG8_SP2>(F.lds + RING_OFF, g, S, E); }
        PNL_BAR();
    }
    if (IN(9)) { p9_final(F, X3B); }
#undef IN
#undef GRID_BAR
#undef GRP_BAR
#undef PNL_BAR
}

extern "C" void kernel_launch(void* const* d_in, const int* in_sizes, int n_in, void* d_out, int out_size, void* d_ws, size_t ws_size, hipStream_t stream) {
    static int grid = 0;
    if (grid == 0) {
        if (n_in != 16 || in_sizes[0] != M * DM || out_size != M * DM || ws_size < WS_END) { fprintf(stderr, "kernel_launch: shape/workspace mismatch (n_in %d, in0 %d, out %d, ws %zu, need %zu); nothing launched\n", n_in, n_in > 0 ? in_sizes[0] : -1, out_size, ws_size, (size_t)WS_END); grid = -1; return; }
        int dev = 0, cus = 0, per_cu = 0;
        if (hipGetDevice(&dev) != hipSuccess || hipDeviceGetAttribute(&cus, hipDeviceAttributeMultiprocessorCount, dev) != hipSuccess) { fprintf(stderr, "kernel_launch: device query failed\n"); grid = -1; return; }
        if (hipFuncSetAttribute((const void*)mk_fwd, hipFuncAttributeMaxDynamicSharedMemorySize, LDS_BYTES) != hipSuccess) { fprintf(stderr, "kernel_launch: hipFuncSetAttribute failed\n"); grid = -1; return; }
        if (hipOccupancyMaxActiveBlocksPerMultiprocessor(&per_cu, (const void*)mk_fwd, NWAVES * 64, LDS_BYTES) != hipSuccess || per_cu < 1) { fprintf(stderr, "kernel_launch: occupancy query reports %d workgroups per CU\n", per_cu); }
        (void)hipGetLastError();
        if (cus != 256) { fprintf(stderr, "kernel_launch: %d CUs; this kernel's batch-group layout needs 256\n", cus); grid = -1; return; }
        grid = cus;
    }
    if (grid < 0) return;
    if (hipMemsetAsync((char*)d_ws + WS_CTL, 0, CTL_ZERO_BYTES, stream) != hipSuccess) { fprintf(stderr, "kernel_launch: memset failed\n"); return; }
    Args a{};
    for (int i = 0; i < 16; ++i) a.in[i] = (const float*)d_in[i];
    a.out = (float*)d_out; a.ws = (unsigned char*)d_ws;
    for (int li = 0; li < N_LAUNCHES; ++li) {
        a.ph_lo = (N_LAUNCHES == 1) ? 0 : li; a.ph_hi = (N_LAUNCHES == 1) ? N_PHASES : li + 1;
        hipLaunchKernelGGL(mk_fwd, dim3(grid), dim3(NWAVES * 64), LDS_BYTES, stream, a);
        const hipError_t le = hipPeekAtLastError();
        if (le != hipSuccess) { fprintf(stderr, "kernel_launch: launch %d failed: %s\n", li, hipGetErrorName(le)); break; }
    }
}
```
